# Optimizing an MI355X kernel written in HIP

```python
import math
import jax, jax.numpy as jnp
from jax import lax
import numpy as np

D_MODEL = 1024
BATCH = 8
SEQ = 2048
DEPTH = 1
DEC_BATCH = 128
DEC_SEQ = 1
PAST_LEN = 16384
PAGE_SIZE = 128

GDN_HEADS = 4
GDN_HEAD_DIM = 128
GDN_WIDTH = GDN_HEADS * GDN_HEAD_DIM
CONV_W = 4
GDN_CHUNK = 64
S5_WIDTH = D_MODEL - GDN_WIDTH
S5_GROUP = 16
S5_GROUPS = S5_WIDTH // S5_GROUP
S5_STATE = 64
MIX_WIDTH = GDN_WIDTH + S5_WIDTH
D_FF = 4 * D_MODEL
N_PROJ = 3 * GDN_WIDTH + GDN_WIDTH + 2 * GDN_HEADS + S5_WIDTH
DN_ALPHA = (2.0 * DEPTH) ** 0.25
DN_BETA = (8.0 * DEPTH) ** -0.25
NORM_EPS = 1e-6

kernel_name = "hymba_gdn_s5_deepnorm_step"


def layernorm(x, g, b):
    xf = x.astype(jnp.float32)
    mu = jnp.mean(xf, axis=-1, keepdims=True)
    var = jnp.mean(jnp.square(xf - mu), axis=-1, keepdims=True)
    y = (xf - mu) * lax.rsqrt(var + NORM_EPS) * g.astype(jnp.float32) + b.astype(jnp.float32)
    return y.astype(x.dtype)


def l2norm(a):
    af = a.astype(jnp.float32)
    return af * lax.rsqrt(jnp.sum(af * af, axis=-1, keepdims=True) + NORM_EPS)


def causal_short_conv(x, buf, w):
    xc = jnp.concatenate([buf.astype(x.dtype), x], axis=1)
    y = lax.conv_general_dilated(xc, w[:, None, :].astype(x.dtype), window_strides=(1,), padding='VALID',
                                 dimension_numbers=('NWC', 'WIO', 'NWC'), feature_group_count=x.shape[-1])
    return jax.nn.silu(y), xc[:, xc.shape[1] - (CONV_W - 1):]


def gated_delta_chunked(q, k, v, g, beta, s0):
    f32 = jnp.float32
    bsz, T = q.shape[0], q.shape[1]
    C = min(GDN_CHUNK, T)
    n = -(-T // C)
    pad = n * C - T

    def prep(a):
        a = a.astype(f32)
        if pad:
            a = jnp.pad(a, [(0, 0), (0, pad)] + [(0, 0)] * (a.ndim - 2))
        a = a.reshape((bsz, n, C) + a.shape[2:])
        return jnp.moveaxis(a, (1, 3), (0, 2))

    q, k, v, g, beta = prep(q), prep(k), prep(v), prep(g), prep(beta)
    q = q * (GDN_HEAD_DIM ** -0.5)
    gc = jnp.cumsum(g, axis=-1)
    tri = jnp.tril(jnp.ones((C, C), bool))
    strict = jnp.tril(jnp.ones((C, C), bool), -1)
    diff = gc[..., :, None] - gc[..., None, :]
    decay = jnp.where(tri, jnp.exp(jnp.where(tri, diff, 0.0)), 0.0)
    k_beta = k * beta[..., None]
    v_beta = v * beta[..., None]
    L = jnp.where(strict, jnp.einsum('nbhid,nbhjd->nbhij', k_beta, k) * decay, 0.0)
    rhs = jnp.concatenate([v_beta, k_beta * jnp.exp(gc)[..., None]], axis=-1)
    sol = lax.linalg.triangular_solve(L + jnp.eye(C, dtype=f32), rhs, left_side=True, lower=True,
                                      unit_diagonal=True)
    u = sol[..., :GDN_HEAD_DIM]
    w = sol[..., GDN_HEAD_DIM:]
    qk = jnp.where(tri, jnp.einsum('nbhid,nbhjd->nbhij', q, k) * decay, 0.0)

    def step(S, xs):
        q_c, k_c, u_c, w_c, qk_c, gc_c = xs
        v_new = u_c - jnp.einsum('bhcd,bhde->bhce', w_c, S)
        o = (jnp.einsum('bhcd,bhde->bhce', q_c * jnp.exp(gc_c)[..., None], S)
             + jnp.einsum('bhij,bhje->bhie', qk_c, v_new))
        g_last = gc_c[..., -1]
        S = (S * jnp.exp(g_last)[..., None, None]
             + jnp.einsum('bhcd,bhce->bhde', k_c * jnp.exp(g_last[..., None] - gc_c)[..., None], v_new))
        return S, o

    S, o = lax.scan(step, s0.astype(f32), (q, k, u, w, qk, gc))
    o = jnp.moveaxis(o, (0, 2), (1, 3)).reshape(bsz, n * C, GDN_HEADS, GDN_HEAD_DIM)[:, :T]
    return o, S


def s5_scan(u, h0_re, h0_im, a_re, a_im, b_re, b_im, c_re, c_im, d_skip, log_dt):
    f32 = jnp.float32
    bsz, T = u.shape[0], u.shape[1]
    uf = u.astype(f32)
    lam = lax.complex(a_re.astype(f32), a_im.astype(f32))
    dt = jnp.exp(log_dt.astype(f32))[:, None]
    lam_bar = jnp.exp(lam * dt)
    b_bar = ((lam_bar - 1.0) / lam)[..., None] * lax.complex(b_re.astype(f32), b_im.astype(f32))
    bu = jnp.einsum('gpc,btgc->btgp', b_bar, uf.reshape(bsz, T, S5_GROUPS, S5_GROUP).astype(jnp.complex64))
    h0 = lax.complex(h0_re.astype(f32), h0_im.astype(f32))
    bu = bu.at[:, 0].add(lam_bar * h0)
    a = jnp.broadcast_to(lam_bar, bu.shape)

    def combine(left, right):
        a1, b1 = left
        a2, b2 = right
        return a1 * a2, a2 * b1 + b2

    _, h = lax.associative_scan(combine, (a, bu), axis=1)
    c = lax.complex(c_re.astype(f32), c_im.astype(f32))
    y = jnp.real(jnp.einsum('gcp,btgp->btgc', c, h)).reshape(bsz, T, S5_WIDTH) + d_skip.astype(f32) * uf
    h_last = h[:, -1]
    return y, jnp.real(h_last), jnp.imag(h_last)


def hybrid_layer(x, conv_buf, s_gdn, h_re, h_im, w_in, w_conv, gdn_a_log, gdn_dt_bias, gdn_norm_w,
                 s5_a_re, s5_a_im, s5_b_re, s5_b_im, s5_c_re, s5_c_im, s5_d, s5_log_dt, w_glu, b_glu,
                 w_out, ln1_g, ln1_b, w_ff1, w_ff2, ln2_g, ln2_b):
    f32 = jnp.float32
    bsz, T, _ = x.shape
    proj = jnp.einsum('btd,dn->btn', x, w_in)
    i0 = 3 * GDN_WIDTH
    i1 = i0 + GDN_WIDTH
    i2 = i1 + GDN_HEADS
    i3 = i2 + GDN_HEADS
    qkv_raw, z, b_logit, a_logit, u = (proj[..., :i0], proj[..., i0:i1], proj[..., i1:i2],
                                        proj[..., i2:i3], proj[..., i3:])
    qkv, new_conv = causal_short_conv(qkv_raw, conv_buf, w_conv)
    q = l2norm(qkv[..., :GDN_WIDTH].reshape(bsz, T, GDN_HEADS, GDN_HEAD_DIM))
    k = l2norm(qkv[..., GDN_WIDTH:2 * GDN_WIDTH].reshape(bsz, T, GDN_HEADS, GDN_HEAD_DIM))
    v = qkv[..., 2 * GDN_WIDTH:].reshape(bsz, T, GDN_HEADS, GDN_HEAD_DIM)
    beta = jax.nn.sigmoid(b_logit.astype(f32))
    g = -jnp.exp(gdn_a_log.astype(f32)) * jax.nn.softplus(a_logit.astype(f32) + gdn_dt_bias.astype(f32))
    o, s_new = gated_delta_chunked(q, k, v, g, beta, s_gdn)
    o = (o * lax.rsqrt(jnp.mean(o * o, axis=-1, keepdims=True) + NORM_EPS) * gdn_norm_w.astype(f32)
         * jax.nn.silu(z.astype(f32).reshape(bsz, T, GDN_HEADS, GDN_HEAD_DIM)))
    o = o.reshape(bsz, T, GDN_WIDTH).astype(x.dtype)
    ys, hr, hi = s5_scan(u, h_re, h_im, s5_a_re, s5_a_im, s5_b_re, s5_b_im, s5_c_re, s5_c_im, s5_d, s5_log_dt)
    ys = jax.nn.gelu(ys).astype(x.dtype)
    ys = ys * jax.nn.sigmoid(jnp.einsum('btc,ce->bte', ys, w_glu) + b_glu)
    mix = jnp.einsum('btc,cd->btd', jnp.concatenate([o, ys], axis=-1), w_out)
    x = layernorm(DN_ALPHA * x + mix, ln1_g, ln1_b)
    h = jnp.square(jax.nn.relu(jnp.einsum('btd,df->btf', x, w_ff1)))
    x = layernorm(DN_ALPHA * x + jnp.einsum('btf,fd->btd', h, w_ff2), ln2_g, ln2_b)
    return x, new_conv, s_new, hr, hi


def setup_inputs(seed: int = 0) -> dict:
    key = jax.random.key(seed)
    ks = jax.random.split(key, 32)
    f32 = jnp.float32

    def nrm(k, shape, s):
        return s * jax.random.normal(k, shape, f32)

    x_prompt = nrm(ks[0], (BATCH, SEQ, D_MODEL), 1.0)
    x_sample = nrm(ks[1], (DEC_BATCH, DEC_SEQ, D_MODEL), 1.0)
    state_gdn = nrm(ks[2], (DEPTH, DEC_BATCH, GDN_HEADS, GDN_HEAD_DIM, GDN_HEAD_DIM), 0.1)
    state_conv = nrm(ks[3], (DEPTH, DEC_BATCH, CONV_W - 1, 3 * GDN_WIDTH), 1.0)
    state_ssm_re = nrm(ks[4], (DEPTH, DEC_BATCH, S5_GROUPS, S5_STATE), 0.1)
    state_ssm_im = nrm(ks[5], (DEPTH, DEC_BATCH, S5_GROUPS, S5_STATE), 0.1)
    col_scale = jnp.concatenate([jnp.ones((2 * GDN_WIDTH,), f32), jnp.full((GDN_WIDTH,), DN_BETA, f32),
                                 jnp.ones((GDN_WIDTH + 2 * GDN_HEADS,), f32), jnp.full((S5_WIDTH,), DN_BETA, f32)])
    w_in = nrm(ks[6], (DEPTH, D_MODEL, N_PROJ), D_MODEL ** -0.5) * col_scale
    w_conv = nrm(ks[7], (DEPTH, CONV_W, 3 * GDN_WIDTH), CONV_W ** -0.5)
    gdn_a_log = jnp.log(jax.random.uniform(ks[8], (DEPTH, GDN_HEADS), f32, 1.0, 16.0))
    dt = jnp.exp(jax.random.uniform(ks[9], (DEPTH, GDN_HEADS), f32, math.log(1e-3), math.log(1e-1)))
    gdn_dt_bias = dt + jnp.log(-jnp.expm1(-dt))
    gdn_norm_w = 1.0 + nrm(ks[10], (DEPTH, GDN_HEAD_DIM), 0.02)
    s5_a_re = -0.5 + nrm(ks[11], (DEPTH, S5_GROUPS, S5_STATE), 0.01)
    s5_a_im = jnp.pi * jnp.arange(S5_STATE, dtype=f32) + nrm(ks[12], (DEPTH, S5_GROUPS, S5_STATE), 0.01)
    s5_b_re = nrm(ks[13], (DEPTH, S5_GROUPS, S5_STATE, S5_GROUP), (2 * S5_GROUP) ** -0.5)
    s5_b_im = nrm(ks[14], (DEPTH, S5_GROUPS, S5_STATE, S5_GROUP), (2 * S5_GROUP) ** -0.5)
    s5_c_re = nrm(ks[15], (DEPTH, S5_GROUPS, S5_GROUP, S5_STATE), S5_STATE ** -0.5)
    s5_c_im = nrm(ks[16], (DEPTH, S5_GROUPS, S5_GROUP, S5_STATE), S5_STATE ** -0.5)
    s5_d = nrm(ks[17], (DEPTH, S5_WIDTH), 1.0)
    s5_log_dt = jax.random.uniform(ks[18], (DEPTH, S5_GROUPS), f32, math.log(1e-3), math.log(1e-1))
    w_glu = nrm(ks[19], (DEPTH, S5_WIDTH, S5_WIDTH), S5_WIDTH ** -0.5)
    b_glu = nrm(ks[20], (DEPTH, S5_WIDTH), 0.01)
    w_out = nrm(ks[21], (DEPTH, MIX_WIDTH, D_MODEL), MIX_WIDTH ** -0.5 * DN_BETA)
    ln1_g = 1.0 + nrm(ks[22], (DEPTH, D_MODEL), 0.02)
    ln1_b = nrm(ks[23], (DEPTH, D_MODEL), 0.01)
    w_ff1 = nrm(ks[24], (DEPTH, D_MODEL, D_FF), D_MODEL ** -0.5)
    w_ff2 = nrm(ks[25], (DEPTH, D_FF, D_MODEL), D_FF ** -0.5 * DN_BETA)
    ln2_g = 1.0 + nrm(ks[26], (DEPTH, D_MODEL), 0.02)
    ln2_b = nrm(ks[27], (DEPTH, D_MODEL), 0.01)
    return {"x_prompt": x_prompt, "x_sample": x_sample, "state_gdn": state_gdn, "state_conv": state_conv,
            "state_ssm_re": state_ssm_re, "state_ssm_im": state_ssm_im, "w_in": w_in, "w_conv": w_conv,
            "gdn_a_log": gdn_a_log, "gdn_dt_bias": gdn_dt_bias, "gdn_norm_w": gdn_norm_w,
            "s5_a_re": s5_a_re, "s5_a_im": s5_a_im, "s5_b_re": s5_b_re, "s5_b_im": s5_b_im,
            "s5_c_re": s5_c_re, "s5_c_im": s5_c_im, "s5_d": s5_d, "s5_log_dt": s5_log_dt,
            "w_glu": w_glu, "b_glu": b_glu, "w_out": w_out, "ln1_g": ln1_g, "ln1_b": ln1_b,
            "w_ff1": w_ff1, "w_ff2": w_ff2, "ln2_g": ln2_g, "ln2_b": ln2_b}


def reference(x_prompt, x_sample, state_gdn, state_conv, state_ssm_re, state_ssm_im, w_in, w_conv,
              gdn_a_log, gdn_dt_bias, gdn_norm_w, s5_a_re, s5_a_im, s5_b_re, s5_b_im, s5_c_re, s5_c_im,
              s5_d, s5_log_dt, w_glu, b_glu, w_out, ln1_g, ln1_b, w_ff1, w_ff2, ln2_g, ln2_b):
    f32 = jnp.float32
    bp = x_prompt.shape[0]
    yp, ys = x_prompt, x_sample
    p_gdn, p_conv, p_re, p_im = [], [], [], []
    s_gdn, s_conv, s_re, s_im = [], [], [], []
    for l in range(DEPTH):
        params = (w_in[l], w_conv[l], gdn_a_log[l], gdn_dt_bias[l], gdn_norm_w[l], s5_a_re[l], s5_a_im[l],
                  s5_b_re[l], s5_b_im[l], s5_c_re[l], s5_c_im[l], s5_d[l], s5_log_dt[l], w_glu[l], b_glu[l],
                  w_out[l], ln1_g[l], ln1_b[l], w_ff1[l], w_ff2[l], ln2_g[l], ln2_b[l])
        yp, c, s, hr, hi = hybrid_layer(
            yp, jnp.zeros((bp, CONV_W - 1, 3 * GDN_WIDTH), x_prompt.dtype),
            jnp.zeros((bp, GDN_HEADS, GDN_HEAD_DIM, GDN_HEAD_DIM), f32),
            jnp.zeros((bp, S5_GROUPS, S5_STATE), f32), jnp.zeros((bp, S5_GROUPS, S5_STATE), f32), *params)
        p_gdn.append(s)
        p_conv.append(c)
        p_re.append(hr)
        p_im.append(hi)
        ys, c, s, hr, hi = hybrid_layer(ys, state_conv[l], state_gdn[l], state_ssm_re[l], state_ssm_im[l], *params)
        s_gdn.append(s)
        s_conv.append(c)
        s_re.append(hr)
        s_im.append(hi)
    return (yp, ys, jnp.stack(p_gdn), jnp.stack(p_conv), jnp.stack(p_re), jnp.stack(p_im),
            jnp.stack(s_gdn), jnp.stack(s_conv), jnp.stack(s_re), jnp.stack(s_im))
```

```cpp
#include <hip/hip_runtime.h>
#include <hip/hip_cooperative_groups.h>
#include <cstdio>
#include <cstdint>
namespace cg = cooperative_groups;
namespace pg8 {
#define PG8_LAS __attribute__((address_space(3)))
typedef unsigned short bf16_t;
typedef short bf16x8 __attribute__((ext_vector_type(8)));
typedef float f32x4 __attribute__((ext_vector_type(4)));
typedef unsigned u32x4 __attribute__((ext_vector_type(4)));
constexpr int BM = 256, BK = 64, HALF = 128, HTB = HALF * BK * 2  , STAGE_BYTES = 8 * HTB, NXCD = 8, WGM = 8;

__host__ __device__ __forceinline__ int lds_byte(int r, int c) { const int st = (r >> 4) * 2 + (c >> 5), rr = r & 15, cc = c & 31, ob = rr * 64 + cc * 2; return st * 1024 + (ob ^ (((ob >> 9) & 1) << 5)); }
__host__ __device__ __forceinline__ void stage_rc(int b, int& R, int& C) { const int st = b / 1024, sb = b % 1024, swz = sb ^ (((sb >> 9) & 1) << 5); R = (st >> 1) * 16 + swz / 64; C = (st & 1) * 32 + (swz % 64) / 2; }
__host__ __device__ __forceinline__ int perm32(int rho) { const int n = rho >> 4, i = rho & 15; return 8 * (i >> 2) + 4 * n + (i & 3); }

struct Unit { int pm, pn; };
struct Gemm { const bf16_t* A; const bf16_t* Bt; int M, N, K, lda; };

struct StaticOrder {
    int nM, nN, nwg, G, c;
    __host__ __device__ void init(int M, int N, int G_, int c_) { nM = M / BM; nN = N / BM; nwg = nM * nN; G = G_; c = c_; }
    __host__ __device__ bool next(int i, Unit& u) const {
        const long L = (long)i * G + c; if (L >= nwg) return false;
        int wgid = (int)L; { const int q = nwg / NXCD, r = nwg % NXCD, xcd = wgid % NXCD, off = wgid / NXCD; wgid = (xcd < r ? xcd * (q + 1) : r * (q + 1) + (xcd - r) * q) + off; }
        const int nig = WGM * nN, gid = wgid / nig, fm = gid * WGM, gsz = (nM - fm) < WGM ? (nM - fm) : WGM;
        u.pm = fm + ((wgid % nig) % gsz); u.pn = (wgid % nig) / gsz; return true;
    }
    __device__ __forceinline__ void a_ready(const Unit&) const {}
    __device__ __forceinline__ void done(const Unit&) const {}
};

__device__ __forceinline__ unsigned cvt_pk_bf16(float lo, float hi) { unsigned r; asm volatile("v_cvt_pk_bf16_f32 %0, %1, %2" : "=v"(r) : "v"(lo), "v"(hi)); return r; }
typedef float f32x2 __attribute__((ext_vector_type(2)));
__device__ __forceinline__ f32x2 gelu_pk(f32x2 v) {
    const f32x2 av = __builtin_elementwise_abs(v), d = av * 0.2316418882f + 1.0f;
    f32x2 t; t.x = __builtin_amdgcn_rcpf(d.x); t.y = __builtin_amdgcn_rcpf(d.y);
    f32x2 q = t * 0.5307027145f + (-0.7265760135f); q = q * t + 0.7107068705f; q = q * t + (-0.142248368f); q = q * t + 0.127414796f; q = q * t;
    const f32x2 s = (v * v) * (-0.72134752044f);
    f32x2 e; e.x = __builtin_amdgcn_exp2f(s.x); e.y = __builtin_amdgcn_exp2f(s.y);
    const f32x2 m = v * (q * e), r = v - m;
    f32x2 o; o.x = v.x < 0.f ? m.x : r.x; o.y = v.y < 0.f ? m.y : r.y; return o;
}

template <int ACT  > struct EpiBf16 {
    static constexpr bool PERM = true, AFTER_DRAIN = false; static_assert(ACT == 0 || ACT == 1, "EpiBf16: ACT is 0 (none) or 1 (gelu_pk)");
    bf16_t* O; int ldc; const float* bias; int split_cols; size_t split_stride; float scale0;
    __device__ __forceinline__ void operator()(const f32x4 (&acc)[2][2][4][2], const Unit& u, int wr, int wc, int fr, int fq) const {
        const int row0 = u.pm * BM + wr * 64 + fr; int colt = u.pn * BM; bf16_t* base = O;
        float sc = 1.f; if (split_cols) { const int t = colt / split_cols; base += (size_t)t * split_stride; colt -= t * split_cols; if (t == 0) sc = scale0; }
        const int col0 = colt + wc * 32 + 8 * fq, bcol0 = u.pn * BM + wc * 32 + 8 * fq;
        f32x4 bv[2][2];
#pragma unroll
        for (int bj = 0; bj < 2; ++bj)
#pragma unroll
            for (int n = 0; n < 2; ++n) bv[bj][n] = bias ? *(const f32x4*)(bias + bcol0 + bj * HALF + 4 * n) : (f32x4){0.f, 0.f, 0.f, 0.f};
#pragma unroll
        for (int ai = 0; ai < 2; ++ai)
#pragma unroll
            for (int m = 0; m < 4; ++m) { bf16_t* rowp = base + (size_t)(row0 + ai * HALF + m * 16) * ldc + col0;
#pragma unroll
                for (int bj = 0; bj < 2; ++bj) { f32x4 v0 = acc[ai][bj][m][0] + bv[bj][0], v1 = acc[ai][bj][m][1] + bv[bj][1];
                    if (ACT == 1) { f32x2 a = gelu_pk((f32x2){v0[0], v0[1]}), b = gelu_pk((f32x2){v0[2], v0[3]}), c = gelu_pk((f32x2){v1[0], v1[1]}), d = gelu_pk((f32x2){v1[2], v1[3]});
                        v0 = (f32x4){a.x, a.y, b.x, b.y}; v1 = (f32x4){c.x, c.y, d.x, d.y}; }
                    v0 = v0 * sc; v1 = v1 * sc; u32x4 w; w.x = cvt_pk_bf16(v0[0], v0[1]); w.y = cvt_pk_bf16(v0[2], v0[3]); w.z = cvt_pk_bf16(v1[0], v1[1]); w.w = cvt_pk_bf16(v1[2], v1[3]);
                    *(u32x4*)(rowp + bj * HALF) = w; } }
    }
};
struct EpiGlu {
    static constexpr bool PERM = true, AFTER_DRAIN = false;
    bf16_t* O; int ldo, ocol0; const bf16_t* Y; int ldy, ycol0; const float* bias;
    __device__ __forceinline__ void operator()(const f32x4 (&acc)[2][2][4][2], const Unit& u, int wr, int wc, int fr, int fq) const {
        const int row0 = u.pm * BM + wr * 64 + fr, col0 = u.pn * BM + wc * 32 + 8 * fq;
#pragma unroll
        for (int ai = 0; ai < 2; ++ai)
#pragma unroll
            for (int m = 0; m < 4; ++m) { const size_t row = (size_t)(row0 + ai * HALF + m * 16);
#pragma unroll
                for (int bj = 0; bj < 2; ++bj) { const int col = col0 + bj * HALF;
                    const f32x4 b0 = *(const f32x4*)(bias + col), b1 = *(const f32x4*)(bias + col + 4);
                    const u32x4 yv = *(const u32x4*)(Y + row * ldy + ycol0 + col);
                    const f32x4 v0 = acc[ai][bj][m][0] + b0, v1 = acc[ai][bj][m][1] + b1;
                    float y[8], o[8];
#pragma unroll
                    for (int q = 0; q < 4; ++q) { y[2 * q] = __uint_as_float(yv[q] << 16); y[2 * q + 1] = __uint_as_float(yv[q] & 0xffff0000u); }
#pragma unroll
                    for (int q = 0; q < 4; ++q) { o[q] = y[q] / (1.f + __expf(-v0[q])); o[4 + q] = y[4 + q] / (1.f + __expf(-v1[q])); }
                    u32x4 w; w.x = cvt_pk_bf16(o[0], o[1]); w.y = cvt_pk_bf16(o[2], o[3]); w.z = cvt_pk_bf16(o[4], o[5]); w.w = cvt_pk_bf16(o[6], o[7]);
                    *(u32x4*)(O + row * ldo + ocol0 + col) = w; } }
    }
};
struct EpiRelu2 {
    static constexpr bool PERM = true, AFTER_DRAIN = false;
    bf16_t* O; int ldc;
    __device__ __forceinline__ void operator()(const f32x4 (&acc)[2][2][4][2], const Unit& u, int wr, int wc, int fr, int fq) const {
        const int row0 = u.pm * BM + wr * 64 + fr, col0 = u.pn * BM + wc * 32 + 8 * fq;
#pragma unroll
        for (int ai = 0; ai < 2; ++ai)
#pragma unroll
            for (int m = 0; m < 4; ++m) { bf16_t* rowp = O + (size_t)(row0 + ai * HALF + m * 16) * ldc + col0;
#pragma unroll
                for (int bj = 0; bj < 2; ++bj) { f32x4 v0 = acc[ai][bj][m][0], v1 = acc[ai][bj][m][1];
#pragma unroll
                    for (int q = 0; q < 4; ++q) { const float a = fmaxf(v0[q], 0.f), b = fmaxf(v1[q], 0.f); v0[q] = a * a; v1[q] = b * b; }
                    u32x4 w; w.x = cvt_pk_bf16(v0[0], v0[1]); w.y = cvt_pk_bf16(v0[2], v0[3]); w.z = cvt_pk_bf16(v1[0], v1[1]); w.w = cvt_pk_bf16(v1[2], v1[3]);
                    *(u32x4*)(rowp + bj * HALF) = w; } }
    }
};
struct EpiResF32 {
    static constexpr bool PERM = false, AFTER_DRAIN = false;
    const float* resP; const float* resS; float* out; float alpha; int split, nrows;
    __device__ __forceinline__ void operator()(const f32x4 (&acc)[2][2][4][2], const Unit& u, int wr, int wc, int fr, int fq) const {
        const int row0 = u.pm * BM + wr * 64 + fr, col0 = u.pn * BM + wc * 32 + 4 * fq;
#pragma unroll
        for (int ai = 0; ai < 2; ++ai)
#pragma unroll
            for (int m = 0; m < 4; ++m) { const int row = row0 + ai * HALF + m * 16;
                if (row < nrows) {
                    const float* rp = (row < split ? resP + (size_t)row * 1024 : resS + (size_t)(row - split) * 1024) + col0;
                    float* op = out + (size_t)row * 1024 + col0;
#pragma unroll
                    for (int bj = 0; bj < 2; ++bj)
#pragma unroll
                        for (int n = 0; n < 2; ++n) { const f32x4 r = *(const f32x4*)(rp + bj * HALF + n * 16); *(f32x4*)(op + bj * HALF + n * 16) = r * alpha + acc[ai][bj][m][n]; }
                } }
    }
};
template <class Epi, class Sched, bool ALIGN_EPI = false, bool SP2 = false>
__device__ __forceinline__ void gemm_phase(PG8_LAS unsigned char* lds, const Gemm g, const Sched& S, const Epi& E) {
    const int tid = threadIdx.x, wid = __builtin_amdgcn_readfirstlane(tid >> 6), lane = tid & 63, wr = wid >> 2, wc = wid & 3, fr = lane & 15, fq = lane >> 4;
    const int K = g.K, nt = K / BK;
    unsigned voffA[2], voffB[2];
#pragma unroll
    for (int i = 0; i < 2; ++i) { int R, C; stage_rc(tid * 16 + i * 8192, R, C); const int Rb = Epi::PERM ? ((R & ~31) + perm32(R & 31)) : R;
        voffA[i] = (unsigned)(R * g.lda + C) * 2u; voffB[i] = (unsigned)(Rb * K + C) * 2u; }
    const size_t kstep = (size_t)(BK * 2);
    const size_t hstepA = (size_t)HALF * g.lda * 2, hstepB = (size_t)HALF * K * 2;
    const size_t tstepA = 2 * hstepA, tstepB = 2 * hstepB;
    const unsigned ldsw = (unsigned)wid * 1024u;
    const int aoff = lds_byte(wr * 64 + fr, fq * 8), boff = lds_byte(wc * 32 + fr, fq * 8);
#define PG8_SA(b, h) (((b) * 2 + (h)) * HTB)
#define PG8_SB(b, h) ((4 + (b) * 2 + (h)) * HTB)
#define PG8_STAGE(bufoff, gbase, voff) do { _Pragma("unroll") for (int _i = 0; _i < 2; ++_i) \
        __builtin_amdgcn_global_load_lds((const unsigned*)((const char*)(gbase) + (voff)[_i]), (PG8_LAS unsigned*)(lds + (bufoff) + ldsw + _i * 8192), 16, 0, 0); } while (0)
#define PG8_LDA(dst, b, h) do { _Pragma("unroll") for (int m = 0; m < 4; ++m) _Pragma("unroll") for (int k = 0; k < 2; ++k) dst[m][k] = *(const PG8_LAS bf16x8*)(lds + PG8_SA(b, h) + aoff + m * 2048 + k * 1024); } while (0)
#define PG8_LDB(dst, b, h) do { _Pragma("unroll") for (int n = 0; n < 2; ++n) _Pragma("unroll") for (int k = 0; k < 2; ++k) dst[n][k] = *(const PG8_LAS bf16x8*)(lds + PG8_SB(b, h) + boff + n * 2048 + k * 1024); } while (0)
#define PG8_MMA(ai, bj, At, Bt) do { __builtin_amdgcn_s_setprio(1); _Pragma("unroll") for (int m = 0; m < 4; ++m) _Pragma("unroll") for (int n = 0; n < 2; ++n) _Pragma("unroll") for (int k = 0; k < 2; ++k) \
        acc[ai][bj][m][n] = __builtin_amdgcn_mfma_f32_16x16x32_bf16(Bt[n][k], At[m][k], acc[ai][bj][m][n], 0, 0, 0); __builtin_amdgcn_s_setprio(0); } while (0)
#define PG8_WAIT_V(n) asm volatile("s_waitcnt vmcnt(" #n ")" ::: "memory")
#define PG8_WAIT_L(n) asm volatile("s_waitcnt lgkmcnt(" #n ")" ::: "memory")
#define PG8_BAR __builtin_amdgcn_s_barrier()
#define PG8_SCHED __builtin_amdgcn_sched_barrier(0)
    Unit cur, nxt; int ui = 0;
    if (!S.next(0, cur)) return;
    f32x4 acc[2][2][4][2];
#pragma unroll
    for (int a = 0; a < 2; ++a)
#pragma unroll
        for (int b = 0; b < 2; ++b)
#pragma unroll
            for (int m = 0; m < 4; ++m)
#pragma unroll
                for (int n = 0; n < 2; ++n) acc[a][b][m][n] = (f32x4){0.f, 0.f, 0.f, 0.f};
    bf16x8 At[4][2], B0[2][2], B1[2][2];
    const char* cA = (const char*)g.A + (size_t)cur.pm * tstepA; const char* cB = (const char*)g.Bt + (size_t)cur.pn * tstepB;
    S.a_ready(cur);
    if constexpr (SP2) {
        PG8_STAGE(PG8_SB(0, 0), cB, voffB); PG8_STAGE(PG8_SB(0, 1), cB + hstepB, voffB); PG8_STAGE(PG8_SA(0, 0), cA, voffA); PG8_STAGE(PG8_SA(0, 1), cA + hstepA, voffA);
        if (wr == 1) PG8_BAR;
        PG8_WAIT_V(2); PG8_BAR;
        PG8_STAGE(PG8_SB(1, 0), cB + kstep, voffB); PG8_STAGE(PG8_SA(1, 0), cA + kstep, voffA); PG8_STAGE(PG8_SB(1, 1), cB + hstepB + kstep, voffB);
        PG8_WAIT_V(6); PG8_BAR;
    } else {
        PG8_STAGE(PG8_SB(0, 0), cB, voffB); PG8_STAGE(PG8_SA(0, 0), cA, voffA); PG8_STAGE(PG8_SB(0, 1), cB + hstepB, voffB); PG8_STAGE(PG8_SA(0, 1), cA + hstepA, voffA);
        if (wr == 1) PG8_BAR;
        PG8_WAIT_V(4); PG8_BAR;
        PG8_STAGE(PG8_SB(1, 0), cB + kstep, voffB); PG8_STAGE(PG8_SA(1, 0), cA + kstep, voffA); PG8_STAGE(PG8_SB(1, 1), cB + hstepB + kstep, voffB);
        PG8_WAIT_V(6); PG8_BAR;
    }
    for (;;) {
        const bool has_next = S.next(ui + 1, nxt);
        const char* nA = has_next ? (const char*)g.A + (size_t)nxt.pm * tstepA : cA; const char* nB = has_next ? (const char*)g.Bt + (size_t)nxt.pn * tstepB : cB;
        for (int t = 0; t < nt; t += 2) {
            const bool last = (t == nt - 2);
            const char* a1 = cA + (size_t)(t + 1) * kstep;
            const char* a2 = last ? nA : cA + (size_t)(t + 2) * kstep; const char* b2 = last ? nB : cB + (size_t)(t + 2) * kstep;
            const char* a3 = a2 + kstep; const char* b3 = b2 + kstep;
            if (last && has_next) S.a_ready(nxt);
            if constexpr (SP2) {
            PG8_LDB(B0, 0, 0); PG8_LDB(B1, 0, 1); PG8_SCHED; PG8_LDA(At, 0, 0); PG8_STAGE(PG8_SA(1, 1), a1 + hstepA, voffA);
            PG8_WAIT_V(8); PG8_WAIT_L(0); PG8_BAR; PG8_MMA(0, 0, At, B0); PG8_MMA(0, 1, At, B1); PG8_BAR; PG8_SCHED;
            PG8_LDA(At, 0, 1); PG8_STAGE(PG8_SB(0, 0), b2, voffB); PG8_STAGE(PG8_SB(0, 1), b2 + hstepB, voffB); PG8_STAGE(PG8_SA(0, 0), a2, voffA);
            PG8_WAIT_V(8); PG8_WAIT_L(0); PG8_BAR; PG8_MMA(1, 0, At, B0); PG8_MMA(1, 1, At, B1); PG8_BAR; PG8_SCHED;
            PG8_LDB(B0, 1, 0); PG8_LDB(B1, 1, 1); PG8_SCHED; PG8_LDA(At, 1, 0); PG8_STAGE(PG8_SA(0, 1), a2 + hstepA, voffA);
            PG8_WAIT_V(8); PG8_WAIT_L(0); PG8_BAR; PG8_MMA(0, 0, At, B0); PG8_MMA(0, 1, At, B1); PG8_BAR; PG8_SCHED;
            PG8_LDA(At, 1, 1); PG8_STAGE(PG8_SB(1, 0), b3, voffB); PG8_STAGE(PG8_SB(1, 1), b3 + hstepB, voffB); PG8_STAGE(PG8_SA(1, 0), a3, voffA);
            PG8_WAIT_V(8); PG8_WAIT_L(0); PG8_BAR; PG8_MMA(1, 0, At, B0); PG8_MMA(1, 1, At, B1); PG8_BAR; PG8_SCHED;
            } else {
            PG8_LDB(B0, 0, 0); PG8_SCHED; PG8_LDA(At, 0, 0); PG8_STAGE(PG8_SA(1, 1), a1 + hstepA, voffA);
            PG8_WAIT_L(8); PG8_BAR; PG8_WAIT_L(0); PG8_MMA(0, 0, At, B0); PG8_BAR; PG8_SCHED;
            PG8_LDB(B1, 0, 1); PG8_STAGE(PG8_SB(0, 0), b2, voffB);
            PG8_BAR; PG8_WAIT_L(0); PG8_MMA(0, 1, At, B1); PG8_BAR;
            PG8_LDA(At, 0, 1); PG8_STAGE(PG8_SA(0, 0), a2, voffA);
            PG8_BAR; PG8_WAIT_L(0); PG8_MMA(1, 0, At, B0); PG8_BAR; PG8_SCHED;
            PG8_STAGE(PG8_SB(0, 1), b2 + hstepB, voffB);
            PG8_WAIT_V(6); PG8_BAR; PG8_MMA(1, 1, At, B1); PG8_BAR;
            PG8_LDB(B0, 1, 0); PG8_SCHED; PG8_LDA(At, 1, 0); PG8_STAGE(PG8_SA(0, 1), a2 + hstepA, voffA);
            PG8_WAIT_L(8); PG8_BAR; PG8_WAIT_L(0); PG8_MMA(0, 0, At, B0); PG8_BAR; PG8_SCHED;
            PG8_LDB(B1, 1, 1); PG8_STAGE(PG8_SB(1, 0), b3, voffB);
            PG8_BAR; PG8_WAIT_L(0); PG8_MMA(0, 1, At, B1); PG8_BAR;
            PG8_LDA(At, 1, 1); PG8_STAGE(PG8_SA(1, 0), a3, voffA);
            PG8_BAR; PG8_WAIT_L(0); PG8_MMA(1, 0, At, B0); PG8_BAR; PG8_SCHED;
            PG8_STAGE(PG8_SB(1, 1), b3 + hstepB, voffB);
            PG8_WAIT_V(6); PG8_BAR; PG8_MMA(1, 1, At, B1); PG8_BAR;
            }
        }
        if constexpr (ALIGN_EPI) { if (wr == 0) PG8_BAR; }
        if constexpr (!Epi::AFTER_DRAIN) { E(acc, cur, wr, wc, fr, fq); S.done(cur); }
        if (!has_next) break;
#pragma unroll
        for (int a = 0; a < 2; ++a)
#pragma unroll
            for (int b = 0; b < 2; ++b)
#pragma unroll
                for (int m = 0; m < 4; ++m)
#pragma unroll
                    for (int n = 0; n < 2; ++n) acc[a][b][m][n] = (f32x4){0.f, 0.f, 0.f, 0.f};
        cur = nxt; cA = nA; cB = nB; ++ui;
        if constexpr (ALIGN_EPI) { if (wr == 1) PG8_BAR; }
    }
    PG8_WAIT_V(0);
    if constexpr (!ALIGN_EPI) { if (wr == 0) PG8_BAR; }
    PG8_BAR;
    if constexpr (Epi::AFTER_DRAIN) { E.fused(acc, cur, wr, wc, fr, fq, lds, wid, lane); S.done(cur); }
#undef PG8_SA
#undef PG8_SB
#undef PG8_STAGE
#undef PG8_LDA
#undef PG8_LDB
#undef PG8_MMA
#undef PG8_WAIT_V
#undef PG8_WAIT_L
#undef PG8_BAR
#undef PG8_SCHED
}
}
#define GAS __attribute__((address_space(1)))
#define LAS __attribute__((address_space(3)))
typedef unsigned short bf16;
typedef unsigned v4u __attribute__((ext_vector_type(4)));
typedef unsigned v2u __attribute__((ext_vector_type(2)));
typedef float f32x4 __attribute__((ext_vector_type(4)));
typedef float f32x16 __attribute__((ext_vector_type(16)));
typedef short bf16x8 __attribute__((ext_vector_type(8)));
#define LDS_WAIT() asm volatile("s_waitcnt lgkmcnt(0)" ::: "memory")
#define WG_BAR() do { asm volatile("s_waitcnt lgkmcnt(0)" ::: "memory"); __builtin_amdgcn_s_barrier(); asm volatile("" ::: "memory"); } while (0)
#define MFMA32(a, b, c) __builtin_amdgcn_mfma_f32_32x32x16_bf16((a), (b), (c), 0, 0, 0)
#define MFMA16(a, b, c) __builtin_amdgcn_mfma_f32_16x16x32_bf16((a), (b), (c), 0, 0, 0)

constexpr int DM = 1024, TSEQ = 2048, MP = 16384, MR = 16512, MPAD = 16640, NPJ = 2560, DFF = 4096;
constexpr int CQ = 0, CK = 512, CV = 1024, CZ = 1536, CU = 2048;
constexpr float DN_ALPHA = 1.189207115002721f, EPS = 1e-6f, QSCALE = 0.08838834764831845f;
constexpr size_t MiB = 1u << 20;
constexpr size_t WS_WI = 1 * MiB, WS_WGLU = 6 * MiB, WS_WO = 6 * MiB + 512 * 1024, WS_W1 = 8 * MiB + 512 * 1024, WS_W2 = 16 * MiB + 512 * 1024;
constexpr size_t WS_MISC = 24 * MiB + 512 * 1024;
constexpr size_t MO_G = 0, MO_BETA = 278528, MO_EG = 557056, MO_LAMB = 573440, MO_LAM32 = 589824, MO_BBAR = 606208;
constexpr size_t WS_XB = 26 * MiB;
constexpr size_t WS_MIXA = 58 * MiB + 512 * 1024;
constexpr size_t WS_KMAT = WS_MIXA, WS_EPOW = WS_MIXA + 16 * MiB, WS_CPOW = WS_MIXA + 20 * MiB;
constexpr size_t WS_PROJ = 91 * MiB;
constexpr size_t WS_H = 91 * MiB;
constexpr size_t WS_NW = 172 * MiB + 512 * 1024, WS_QG = WS_NW + 16 * MiB, WS_KDT = WS_QG + 16 * MiB, WS_QK = WS_KDT + 16 * MiB;
constexpr size_t WS_END = 229 * MiB;
constexpr int LDS_BYTES = 147456;
constexpr size_t OUT_YS = 16777216, OUT_GDN_P = 16908288, OUT_CONV_P = 17432576, OUT_RE_P = 17469440, OUT_IM_P = 17485824,
                 OUT_GDN_S = 17502208, OUT_CONV_S = 25890816, OUT_RE_S = 26480640, OUT_IM_S = 26742784, OUT_TOTAL = 27004928;

__device__ __forceinline__ unsigned f2bf(float f) { unsigned u = __builtin_bit_cast(unsigned, f); return (u + 0x7fffu + ((u >> 16) & 1u)) >> 16; }
__device__ __forceinline__ unsigned pk2(float lo, float hi) { return f2bf(lo) | (f2bf(hi) << 16); }
__device__ __forceinline__ float bf2f(unsigned short b) { return __uint_as_float((unsigned)b << 16); }
__device__ __forceinline__ float bflo(unsigned w) { return __uint_as_float(w << 16); }
__device__ __forceinline__ float bfhi(unsigned w) { return __uint_as_float(w & 0xffff0000u); }
__device__ __forceinline__ float wave_sum(float v) {
#pragma unroll
    for (int o = 1; o < 64; o <<= 1) v += __shfl_xor(v, o);
    return v;
}
__device__ __forceinline__ float siluf_(float x) { return x / (1.f + __expf(-x)); }
__device__ __forceinline__ float sigmf_(float x) { return 1.f / (1.f + __expf(-x)); }
__device__ __forceinline__ float gelu_tanh(float y) { const float t = 0.7978845608028654f * (y + 0.044715f * y * y * y); const float th = 1.f - 2.f / (1.f + __expf(2.f * t)); return 0.5f * y * (1.f + th); }

__device__ __forceinline__ void p0_tr_item(const float* W, int ldw, int K, int nblk, bf16* WT, LAS float* scr, int item, int lane, int gate_skip) {
    const int kb = item / nblk, nb = item % nblk, k0 = 64 * kb, n0 = 32 * nb;
    const int sc0 = n0 + ((gate_skip && n0 >= 2048) ? 8 : 0);
#pragma unroll 8
    for (int i = 0; i < 32; ++i) { const int kk = 2 * i + (lane >> 5); scr[kk * 33 + (lane & 31)] = W[(size_t)(k0 + kk) * ldw + sc0 + (lane & 31)]; }
    LDS_WAIT();
    const int c = lane & 7;
#pragma unroll
    for (int j = 0; j < 4; ++j) { const int n = (lane >> 3) + 8 * j; const LAS float* s = scr + (8 * c) * 33 + n;
        v4u o; o.x = pk2(s[0 * 33], s[1 * 33]); o.y = pk2(s[2 * 33], s[3 * 33]); o.z = pk2(s[4 * 33], s[5 * 33]); o.w = pk2(s[6 * 33], s[7 * 33]);
        *(v4u*)(WT + (size_t)(n0 + n) * K + k0 + 8 * c) = o; }
    LDS_WAIT();
}

struct Args { const float* in[28]; float* out; unsigned char* ws; };
__device__ __forceinline__ void gdn_g1_unit(LAS unsigned char* lds, int unit, const bf16* PROJ, const float* wconv, const float* Gg, const float* Bg,
                                            float* UT, bf16* NW, bf16* QG, bf16* KDT, bf16* QK, float* EG, int tid, int lane, int wave) {
    const int b = unit >> 7, h = (unit >> 5) & 3, c = unit & 31;
    const int m0 = b * TSEQ + c * 64;
    LAS float* Vf = (LAS float*)lds;
    LAS unsigned char* KNb = lds + 65536;
    LAS unsigned char* QNb = lds + 65536 + 17408;
    LAS float* LM = (LAS float*)(lds + 65536 + 2 * 17408);
    LAS float* GC = (LAS float*)(lds + 65536 + 3 * 17408);
    LAS float* BT = GC + 64;
    LAS float* EX = GC + 128;
    if (tid < 384) {
        const int grp = tid >> 4, mat = grp >> 3, rs = grp & 7, cgm = tid & 15;
        const int col = mat * 512 + h * 128 + 8 * cgm;
        float w[4][8];
#pragma unroll
        for (int j = 0; j < 4; ++j) { const f32x4 a = *(const f32x4*)(wconv + j * 1536 + col), bq = *(const f32x4*)(wconv + j * 1536 + col + 4);
            w[j][0] = a.x; w[j][1] = a.y; w[j][2] = a.z; w[j][3] = a.w; w[j][4] = bq.x; w[j][5] = bq.y; w[j][6] = bq.z; w[j][7] = bq.w; }
        v4u raw[11];
#pragma unroll
        for (int q = 0; q < 11; ++q) { const int i = 8 * rs - 3 + q; const bool ok = (c > 0) || (i >= 0);
            raw[q] = (v4u){0u, 0u, 0u, 0u};
            if (ok) raw[q] = *(const v4u*)(PROJ + (size_t)(m0 + i) * NPJ + col); }
#pragma unroll
        for (int rr = 0; rr < 8; ++rr) {
            float y[8];
#pragma unroll
            for (int cc = 0; cc < 8; ++cc) { float a = 0.f;
#pragma unroll
                for (int j = 0; j < 4; ++j) { const unsigned wd = raw[rr + j][cc >> 1]; const float xv = (cc & 1) ? bfhi(wd) : bflo(wd); a += w[j][cc] * xv; }
                y[cc] = siluf_(a); }
            const int row = 8 * rs + rr;
            if (mat < 2) {
                float ss = 0.f;
#pragma unroll
                for (int cc = 0; cc < 8; ++cc) ss += y[cc] * y[cc];
                ss += __shfl_xor(ss, 1); ss += __shfl_xor(ss, 2); ss += __shfl_xor(ss, 4); ss += __shfl_xor(ss, 8);
                const float rn = rsqrtf(ss + EPS) * (mat == 0 ? QSCALE : 1.f);
                v4u o; o.x = pk2(y[0] * rn, y[1] * rn); o.y = pk2(y[2] * rn, y[3] * rn); o.z = pk2(y[4] * rn, y[5] * rn); o.w = pk2(y[6] * rn, y[7] * rn);
                *(LAS v4u*)((mat == 0 ? QNb : KNb) + row * 272 + cgm * 16) = o;
                if (mat == 1) { *(LAS f32x4*)(Vf + row * 256 + 128 + 8 * cgm) = (f32x4){y[0] * rn, y[1] * rn, y[2] * rn, y[3] * rn};
                                *(LAS f32x4*)(Vf + row * 256 + 128 + 8 * cgm + 4) = (f32x4){y[4] * rn, y[5] * rn, y[6] * rn, y[7] * rn}; }
            } else {
                *(LAS f32x4*)(Vf + row * 256 + 8 * cgm) = (f32x4){y[0], y[1], y[2], y[3]};
                *(LAS f32x4*)(Vf + row * 256 + 8 * cgm + 4) = (f32x4){y[4], y[5], y[6], y[7]};
            }
        }
    } else if (tid < 448) {
        float gl = Gg[(size_t)(m0 + lane) * 4 + h];
#pragma unroll
        for (int o = 1; o < 64; o <<= 1) { const float t = __shfl_up(gl, o); if (lane >= o) gl += t; }
        GC[lane] = gl; BT[lane] = Bg[(size_t)(m0 + lane) * 4 + h]; EX[lane] = __expf(gl) * BT[lane];
    }
    __syncthreads();
    {
        const int mat2 = wave >> 2, tile = wave & 3, ti = tile >> 1, tj = tile & 1;
        const int r = lane & 31, hh = lane >> 5;
        f32x16 acc;
#pragma unroll
        for (int i = 0; i < 16; ++i) acc[i] = 0.f;
        if (ti >= tj) {
            const LAS unsigned char* Ab = (mat2 == 0 ? KNb : QNb) + (32 * ti + r) * 272 + hh * 16;
            const LAS unsigned char* Bb = KNb + (32 * tj + r) * 272 + hh * 16;
#pragma unroll
            for (int ks = 0; ks < 8; ++ks) { const bf16x8 a = *(const LAS bf16x8*)(Ab + ks * 32), bq = *(const LAS bf16x8*)(Bb + ks * 32); acc = MFMA32(a, bq, acc); }
        }
        const int j = 32 * tj + r; const float gcj = GC[j];
        bf16* QKu = QK + (size_t)unit * 4096;
#pragma unroll
        for (int i16 = 0; i16 < 16; ++i16) { const int i = 32 * ti + (i16 & 3) + 8 * (i16 >> 2) + 4 * hh;
            const float dec = __expf(fminf(GC[i] - gcj, 0.f));
            if (mat2 == 0) LM[j * 68 + i] = (i > j) ? BT[i] * acc[i16] * dec : 0.f;
            else QKu[i * 64 + j] = (bf16)f2bf((i >= j) ? acc[i16] * dec : 0.f); }
    }
    __syncthreads();
    if (tid < 256) {
        const int col = tid; float x[64];
        int zo; asm volatile("v_mov_b32 %0, 0" : "=v"(zo));
        const LAS float* LTv = LM + zo;
        const LAS float* SCv = (col < 128 ? BT : EX) + zo;
#pragma unroll
        for (int i = 0; i < 64; ++i) { x[i] = Vf[i * 256 + col] * SCv[i]; if ((i & 7) == 7) { asm volatile("" ::: "memory"); __builtin_amdgcn_sched_barrier(0); } }
#pragma unroll
        for (int m = 0; m < 63; ++m) {
            const float xm = x[m];
#pragma unroll
            for (int q = (m + 1) >> 2; q < 16; ++q) { const f32x4 l = *(const LAS f32x4*)(LTv + m * 68 + 4 * q);
                if (4 * q + 0 > m) x[4 * q + 0] -= l.x * xm;
                if (4 * q + 1 > m) x[4 * q + 1] -= l.y * xm;
                if (4 * q + 2 > m) x[4 * q + 2] -= l.z * xm;
                if (4 * q + 3 > m) x[4 * q + 3] -= l.w * xm; }
            asm volatile("" ::: "memory"); __builtin_amdgcn_sched_barrier(0);
        }
        if (col < 128) { float* ut = UT + (size_t)unit * 8192 + col * 64;
#pragma unroll
            for (int q = 0; q < 16; ++q) *(f32x4*)(ut + 4 * q) = (f32x4){x[4 * q], x[4 * q + 1], x[4 * q + 2], x[4 * q + 3]};
        } else { bf16* nw = NW + (size_t)unit * 8192 + (col - 128);
#pragma unroll
            for (int i = 0; i < 64; ++i) nw[i * 128] = (bf16)f2bf(-x[i]); }
    } else {
        const int t2 = tid - 256; const float gl = GC[63];
        bf16* QGu = QG + (size_t)unit * 8192; bf16* KDu = KDT + (size_t)unit * 8192;
        for (int u = t2; u < 1024; u += 256) { const int i = u >> 4, d8 = u & 15; const v4u q = *(const LAS v4u*)(QNb + i * 272 + d8 * 16); const float e = __expf(GC[i]);
            v4u o; o.x = pk2(bflo(q.x) * e, bfhi(q.x) * e); o.y = pk2(bflo(q.y) * e, bfhi(q.y) * e); o.z = pk2(bflo(q.z) * e, bfhi(q.z) * e); o.w = pk2(bflo(q.w) * e, bfhi(q.w) * e);
            *(v4u*)(QGu + i * 128 + d8 * 8) = o; }
        for (int u = t2; u < 1024; u += 256) { const int d = u >> 3, i8 = u & 7; float v[8];
#pragma unroll
            for (int jj = 0; jj < 8; ++jj) { const int i = 8 * i8 + jj; v[jj] = bf2f(*(const LAS unsigned short*)(KNb + i * 272 + d * 2)) * __expf(gl - GC[i]); }
            v4u o; o.x = pk2(v[0], v[1]); o.y = pk2(v[2], v[3]); o.z = pk2(v[4], v[5]); o.w = pk2(v[6], v[7]);
            *(v4u*)(KDu + d * 64 + 8 * i8) = o; }
        if (t2 == 0) EG[unit] = __expf(gl);
    }
    __syncthreads();
}

__device__ __forceinline__ void gdn_g2_unit(LAS unsigned char* lds, int unit, bf16* PROJ, const float* UT, const bf16* NW, const bf16* QG, const bf16* KDT, const bf16* QK,
                                            const float* EG, float* outS, int tid, int lane, int wave) {
    const int bh = unit >> 3, sl = unit & 7, e0 = sl * 16, b = bh >> 2, h = bh & 3;
    const int fr = lane & 15, fq = lane >> 4; const bool role0 = wave < 4; const int tt = wave & 3;
    LAS unsigned char* Sl = lds;
    LAS unsigned char* Vl = lds + 4352;
    for (int i = tid; i < 4352 / 4; i += 512) ((LAS unsigned*)Sl)[i] = 0u;
    f32x4 Sacc = (f32x4){0.f, 0.f, 0.f, 0.f};
    bf16x8 cA1[4], cA2[2], cKD[2], nA1[4], nA2[2], nKD[2]; f32x4 cU, nU; float cEG, nEG;
#pragma unroll
    for (int k = 0; k < 2; ++k) { cA2[k] = (bf16x8){0, 0, 0, 0, 0, 0, 0, 0}; nA2[k] = cA2[k]; }
    cU = (f32x4){0.f, 0.f, 0.f, 0.f}; nU = cU;
#define G2_LOAD(c_, A1, A2, UU, KD, EGv) do { const size_t ub = (size_t)(bh * 32 + (c_)); \
        const bf16* p1 = (role0 ? NW : QG) + ub * 8192 + (16 * tt + fr) * 128 + 8 * fq; \
        _Pragma("unroll") for (int ks = 0; ks < 4; ++ks) A1[ks] = *(const bf16x8*)(p1 + 32 * ks); \
        if (role0) UU = *(const f32x4*)(UT + ub * 8192 + (e0 + fr) * 64 + 16 * tt + 4 * fq); \
        else { const bf16* p2 = QK + ub * 4096 + (16 * tt + fr) * 64 + 8 * fq; A2[0] = *(const bf16x8*)p2; A2[1] = *(const bf16x8*)(p2 + 32); } \
        const bf16* p3 = KDT + ub * 8192 + (16 * wave + fr) * 64 + 8 * fq; KD[0] = *(const bf16x8*)p3; KD[1] = *(const bf16x8*)(p3 + 32); EGv = EG[ub]; } while (0)
    G2_LOAD(0, cA1, cA2, cU, cKD, cEG);
    WG_BAR();
    for (int c = 0; c < 32; ++c) {
        if (c + 1 < 32) G2_LOAD(c + 1, nA1, nA2, nU, nKD, nEG);
        f32x4 a1 = role0 ? cU : (f32x4){0.f, 0.f, 0.f, 0.f};
#pragma unroll
        for (int ks = 0; ks < 4; ++ks) { const bf16x8 bS = *(const LAS bf16x8*)(Sl + fr * 272 + (32 * ks + 8 * fq) * 2); a1 = MFMA16(cA1[ks], bS, a1); }
        if (role0) { v2u o; o.x = pk2(a1.x, a1.y); o.y = pk2(a1.z, a1.w); *(LAS v2u*)(Vl + fr * 144 + (16 * tt + 4 * fq) * 2) = o; }
        WG_BAR();
        const bf16x8 bV0 = *(const LAS bf16x8*)(Vl + fr * 144 + (8 * fq) * 2), bV1 = *(const LAS bf16x8*)(Vl + fr * 144 + (32 + 8 * fq) * 2);
        if (!role0) {
            a1 = MFMA16(cA2[0], bV0, a1); a1 = MFMA16(cA2[1], bV1, a1);
            bf16* op = PROJ + (size_t)(b * TSEQ + 64 * c + 16 * tt + 4 * fq) * NPJ + CQ + h * 128 + e0 + fr;
            op[0] = (bf16)f2bf(a1.x); op[NPJ] = (bf16)f2bf(a1.y); op[2 * NPJ] = (bf16)f2bf(a1.z); op[3 * NPJ] = (bf16)f2bf(a1.w);
        }
        Sacc = Sacc * cEG;
        Sacc = MFMA16(cKD[0], bV0, Sacc); Sacc = MFMA16(cKD[1], bV1, Sacc);
        { v2u o; o.x = pk2(Sacc.x, Sacc.y); o.y = pk2(Sacc.z, Sacc.w); *(LAS v2u*)(Sl + fr * 272 + (16 * wave + 4 * fq) * 2) = o; }
        WG_BAR();
#pragma unroll
        for (int ks = 0; ks < 4; ++ks) cA1[ks] = nA1[ks];
        cA2[0] = nA2[0]; cA2[1] = nA2[1]; cKD[0] = nKD[0]; cKD[1] = nKD[1]; cU = nU; cEG = nEG;
    }
#undef G2_LOAD
    float* so = outS + ((size_t)bh * 128 + 16 * wave + 4 * fq) * 128 + e0 + fr;
    so[0] = Sacc.x; so[128] = Sacc.y; so[256] = Sacc.z; so[384] = Sacc.w;
    __syncthreads();
}
__device__ __forceinline__ void s5_prompt_unit(LAS unsigned char* lds, int unit, bf16* PROJ, const bf16* KMAT, const bf16* EPOW, const bf16* CPOW, const float* LAM32,
                                               const float* dskip, float* outRe, float* outIm, int tid, int lane, int wave) {
    const int b = unit >> 5, g = unit & 31;
    LAS unsigned char* UL = lds;
    LAS float* EL = (LAS float*)(lds + 66560);
    LAS unsigned char* HL = lds + 66560 + 33792;
    const int r = lane & 31, hh = lane >> 5;
    for (int piece = tid; piece < 4096; piece += 512) { const int tok = piece >> 1, hf = piece & 1;
        const v4u v = *(const v4u*)(PROJ + (size_t)(b * TSEQ + tok) * NPJ + CU + 16 * g + 8 * hf);
        *(LAS v4u*)(UL + (tok >> 5) * 1040 + (tok & 31) * 32 + hf * 16) = v; }
    __syncthreads();
    {
        const int mi = wave & 3, ni = wave >> 2;
        f32x16 acc;
#pragma unroll
        for (int i = 0; i < 16; ++i) acc[i] = 0.f;
        const bf16* ap = EPOW + ((size_t)((g * 4 + mi) * 32) * 64 + lane) * 8;
        const LAS unsigned char* bp = UL + (32 * ni + r) * 1040 + hh * 16;
#pragma unroll 8
        for (int kj = 0; kj < 32; ++kj) { const bf16x8 a = *(const bf16x8*)(ap + (size_t)kj * 512); const bf16x8 bq = *(const LAS bf16x8*)(bp + kj * 32); acc = MFMA32(a, bq, acc); }
#pragma unroll
        for (int i4 = 0; i4 < 4; ++i4) *(LAS f32x4*)(EL + (32 * ni + r) * 132 + 32 * mi + 8 * i4 + 4 * hh) = (f32x4){acc[4 * i4], acc[4 * i4 + 1], acc[4 * i4 + 2], acc[4 * i4 + 3]};
    }
    __syncthreads();
    if (wave == 0) {
        const float lr = LAM32[(g * 64 + lane) * 2], li = LAM32[(g * 64 + lane) * 2 + 1];
        float Hr = 0.f, Hi = 0.f;
        for (int c = 0; c < 64; ++c) {
            *(LAS unsigned short*)(HL + c * 272 + lane * 2) = (unsigned short)f2bf(Hr); *(LAS unsigned short*)(HL + c * 272 + (64 + lane) * 2) = (unsigned short)f2bf(Hi);
            const float er = EL[c * 132 + lane], ei = EL[c * 132 + 64 + lane];
            const float nr = lr * Hr - li * Hi + er, nim = lr * Hi + li * Hr + ei; Hr = nr; Hi = nim; }
        outRe[(size_t)(b * 32 + g) * 64 + lane] = Hr; outIm[(size_t)(b * 32 + g) * 64 + lane] = Hi;
    }
    __syncthreads();
    {
        f32x16 acc[2][2];
#pragma unroll
        for (int a = 0; a < 2; ++a)
#pragma unroll
            for (int n = 0; n < 2; ++n)
#pragma unroll
                for (int i = 0; i < 16; ++i) acc[a][n][i] = 0.f;
        const LAS unsigned char* bp0 = UL + (r) * 1040 + hh * 16; const LAS unsigned char* bp1 = UL + (32 + r) * 1040 + hh * 16;
#pragma unroll
        for (int a = 0; a < 2; ++a) { const int mt = a == 0 ? wave : 15 - wave;
            const bf16* ap = KMAT + ((size_t)((g * 16 + mt) * 32) * 64 + lane) * 8;
            const int nk = 2 * mt + 2;
            for (int kj = 0; kj < nk; ++kj) { const bf16x8 av = *(const bf16x8*)(ap + (size_t)kj * 512);
                const bf16x8 b0 = *(const LAS bf16x8*)(bp0 + kj * 32), b1 = *(const LAS bf16x8*)(bp1 + kj * 32);
                acc[a][0] = MFMA32(av, b0, acc[a][0]); acc[a][1] = MFMA32(av, b1, acc[a][1]); }
            const bf16* cp = CPOW + ((size_t)((g * 16 + mt) * 8) * 64 + lane) * 8;
#pragma unroll
            for (int kj = 0; kj < 8; ++kj) { const bf16x8 av = *(const bf16x8*)(cp + (size_t)kj * 512);
                const bf16x8 b0 = *(const LAS bf16x8*)(HL + r * 272 + (16 * kj + 8 * hh) * 2), b1 = *(const LAS bf16x8*)(HL + (32 + r) * 272 + (16 * kj + 8 * hh) * 2);
                acc[a][0] = MFMA32(av, b0, acc[a][0]); acc[a][1] = MFMA32(av, b1, acc[a][1]); }
        }
#pragma unroll
        for (int a = 0; a < 2; ++a) { const int mt = a == 0 ? wave : 15 - wave;
#pragma unroll
            for (int n = 0; n < 2; ++n)
#pragma unroll
                for (int i4 = 0; i4 < 4; ++i4) { const int ttk = i4 >> 1, c0 = 8 * (i4 & 1) + 4 * hh; const int chunk = 32 * n + r, tl = 2 * mt + ttk;
                    const v2u uu = *(const LAS v2u*)(UL + chunk * 1040 + tl * 32 + c0 * 2);
                    const f32x4 dk = *(const f32x4*)(dskip + 16 * g + c0);
                    const float y0 = acc[a][n][4 * i4] + dk.x * bflo(uu.x), y1 = acc[a][n][4 * i4 + 1] + dk.y * bfhi(uu.x), y2 = acc[a][n][4 * i4 + 2] + dk.z * bflo(uu.y), y3 = acc[a][n][4 * i4 + 3] + dk.w * bfhi(uu.y);
                    v2u o; o.x = pk2(gelu_tanh(y0), gelu_tanh(y1)); o.y = pk2(gelu_tanh(y2), gelu_tanh(y3));
                    *(v2u*)(PROJ + (size_t)(b * TSEQ + 32 * chunk + tl) * NPJ + CU + 16 * g + c0) = o; }
        }
    }
    __syncthreads();
}

__device__ __forceinline__ void gdn_sample_task(LAS unsigned char* lds, int task, bf16* PROJ, const float* wconv, const float* sconv, const float* sgdn, const float* Gg, const float* Bg,
                                                float* outS, float* outConv, int tid, int lane, int wave) {
    const int b = task >> 2, h = task & 3; const int m = MP + b;
    LAS float* qkv = (LAS float*)lds;
    LAS float* red = qkv + 384;
    LAS float* part = qkv + 512;
    LAS float* vnew = part + 1024;
    if (tid < 384) { const int mat = tid >> 7, d = tid & 127, ch = mat * 512 + h * 128 + d;
        const float* sc = sconv + (size_t)b * 3 * 1536 + ch; const float raw = bf2f(PROJ[(size_t)m * NPJ + ch]);
        const float s0 = sc[0], s1 = sc[1536], s2 = sc[3072];
        const float y = wconv[ch] * s0 + wconv[1536 + ch] * s1 + wconv[3072 + ch] * s2 + wconv[4608 + ch] * raw;
        qkv[tid] = siluf_(y);
        float* nc = outConv + (size_t)b * 3 * 1536 + ch; nc[0] = s1; nc[1536] = s2; nc[3072] = raw; }
    __syncthreads();
    if (wave < 3) { const float q0 = qkv[lane], q1 = qkv[64 + lane], k0 = qkv[128 + lane], k1 = qkv[192 + lane];
        float v = wave == 0 ? q0 * q0 + q1 * q1 : (wave == 1 ? k0 * k0 + k1 * k1 : q0 * k0 + q1 * k1);
        v = wave_sum(v); if (lane == 0) red[wave] = v; }
    __syncthreads();
    const float rq = rsqrtf(red[0] + EPS), rk = rsqrtf(red[1] + EPS), qkdot = red[2] * rq * rk * QSCALE;
    const float gv = Gg[(size_t)m * 4 + h], beta = Bg[(size_t)m * 4 + h], eg = __expf(gv);
    const int dg = tid >> 7, e = tid & 127;
    const float* S0 = sgdn + (size_t)(b * 4 + h) * 16384;
    float s[32]; float ks = 0.f, qs = 0.f;
#pragma unroll
    for (int dd = 0; dd < 32; ++dd) { const int d = dg * 32 + dd; s[dd] = S0[d * 128 + e]; ks += qkv[128 + d] * s[dd]; qs += qkv[d] * s[dd]; }
    part[dg * 128 + e] = ks * rk; part[512 + dg * 128 + e] = qs * rq * QSCALE;
    __syncthreads();
    if (tid < 128) { const float ksum = part[e] + part[128 + e] + part[256 + e] + part[384 + e], qsum = part[512 + e] + part[640 + e] + part[768 + e] + part[896 + e];
        const float vn = beta * (qkv[256 + e] - eg * ksum); const float o = eg * qsum + qkdot * vn; vnew[e] = vn;
        PROJ[(size_t)m * NPJ + CQ + h * 128 + e] = (bf16)f2bf(o); }
    __syncthreads();
    { const float vn = vnew[e]; float* So = outS + (size_t)(b * 4 + h) * 16384;
#pragma unroll
        for (int dd = 0; dd < 32; ++dd) { const int d = dg * 32 + dd; So[d * 128 + e] = s[dd] * eg + (qkv[128 + d] * rk) * vn; } }
    __syncthreads();
}

__device__ __forceinline__ void s5_sample_task(int task, bf16* PROJ, const float* LAMB, const float* BBAR, const float* cre, const float* cim, const float* dskip,
                                               const float* sre, const float* sim, float* outRe, float* outIm, int lane) {
    const int b = task >> 5, g = task & 31; const int m = MP + b;
    bf16* up = PROJ + (size_t)m * NPJ + CU + 16 * g;
    const v4u u0 = *(const v4u*)up, u1 = *(const v4u*)(up + 8);
    float u[16];
#pragma unroll
    for (int q = 0; q < 4; ++q) { u[2 * q] = bflo(u0[q]); u[2 * q + 1] = bfhi(u0[q]); u[8 + 2 * q] = bflo(u1[q]); u[8 + 2 * q + 1] = bfhi(u1[q]); }
    const size_t sp = (size_t)(b * 32 + g) * 64 + lane;
    const float h0r = sre[sp], h0i = sim[sp];
    const float lr = LAMB[(g * 64 + lane) * 2], li = LAMB[(g * 64 + lane) * 2 + 1];
    float bur = 0.f, bui = 0.f;
    const float* bb = BBAR + (size_t)(g * 64 + lane) * 32;
#pragma unroll
    for (int c4 = 0; c4 < 8; ++c4) { const f32x4 v = *(const f32x4*)(bb + 4 * c4); bur += v.x * u[2 * c4] + v.z * u[2 * c4 + 1]; bui += v.y * u[2 * c4] + v.w * u[2 * c4 + 1]; }
    const float hr = lr * h0r - li * h0i + bur, hi = lr * h0i + li * h0r + bui;
    outRe[sp] = hr; outIm[sp] = hi;
    float ys[16];
#pragma unroll
    for (int c = 0; c < 16; ++c) { float v = cre[(size_t)(g * 16 + c) * 64 + lane] * hr - cim[(size_t)(g * 16 + c) * 64 + lane] * hi; v = wave_sum(v); ys[c] = gelu_tanh(v + dskip[16 * g + c] * u[c]); }
    if (lane == 0) { v4u o0, o1;
        o0.x = pk2(ys[0], ys[1]); o0.y = pk2(ys[2], ys[3]); o0.z = pk2(ys[4], ys[5]); o0.w = pk2(ys[6], ys[7]);
        o1.x = pk2(ys[8], ys[9]); o1.y = pk2(ys[10], ys[11]); o1.z = pk2(ys[12], ys[13]); o1.w = pk2(ys[14], ys[15]);
        *(v4u*)up = o0; *(v4u*)(up + 8) = o1; }
}

__device__ __forceinline__ void ln_row(float* row, const float* gam, const float* bet, bf16* xb, int lane) {
    f32x4* xr = (f32x4*)row + lane;
    f32x4 v[4]; float s = 0.f;
#pragma unroll
    for (int j = 0; j < 4; ++j) { v[j] = xr[64 * j]; s += (v[j].x + v[j].y) + (v[j].z + v[j].w); }
    const float mean = wave_sum(s) * (1.f / 1024.f); float s2 = 0.f;
#pragma unroll
    for (int j = 0; j < 4; ++j) { v[j] = v[j] - mean; s2 += (v[j].x * v[j].x + v[j].y * v[j].y) + (v[j].z * v[j].z + v[j].w * v[j].w); }
    const float rstd = rsqrtf(wave_sum(s2) * (1.f / 1024.f) + EPS);
#pragma unroll
    for (int j = 0; j < 4; ++j) { const f32x4 gg = *((const f32x4*)gam + lane + 64 * j), bb = *((const f32x4*)bet + lane + 64 * j);
        const f32x4 o = v[j] * rstd * gg + bb; xr[64 * j] = o;
        if (xb) { v2u w; w.x = pk2(o.x, o.y); w.y = pk2(o.z, o.w); *((v2u*)xb + lane + 64 * j) = w; } }
}
#ifndef P2SEL
#define P2SEL 15
#endif
#ifndef PHASES
#define PHASES 255
#endif
__global__ void __launch_bounds__(512, 2) hymba_fwd(Args a) {
    extern __shared__ __attribute__((aligned(16))) unsigned char lds_raw[];
    LAS unsigned char* lds = (LAS unsigned char*)lds_raw;
    cg::grid_group grid = cg::this_grid();
    const int tid = threadIdx.x, lane = tid & 63, wave = __builtin_amdgcn_readfirstlane(tid >> 6);
    const int G = gridDim.x, bid = blockIdx.x;
    const int gw = bid * 8 + wave, NGW = G * 8;
    unsigned char* ws = a.ws;
    const float *xP = a.in[0], *xS = a.in[1], *sgdn = a.in[2], *sconv = a.in[3], *sre = a.in[4], *sim = a.in[5], *w_in = a.in[6], *w_conv = a.in[7],
                *a_log = a.in[8], *dt_bias = a.in[9], *norm_w = a.in[10], *s5are = a.in[11], *s5aim = a.in[12], *s5bre = a.in[13], *s5bim = a.in[14],
                *s5cre = a.in[15], *s5cim = a.in[16], *s5d = a.in[17], *s5ldt = a.in[18], *w_glu = a.in[19], *b_glu = a.in[20], *w_out = a.in[21],
                *ln1g = a.in[22], *ln1b = a.in[23], *w_ff1 = a.in[24], *w_ff2 = a.in[25], *ln2g = a.in[26], *ln2b = a.in[27];
    float* out = a.out;
    bf16 *WI_t = (bf16*)(ws + WS_WI), *WGLU_t = (bf16*)(ws + WS_WGLU), *WO_t = (bf16*)(ws + WS_WO), *W1_t = (bf16*)(ws + WS_W1), *W2_t = (bf16*)(ws + WS_W2);
    float *Gg = (float*)(ws + WS_MISC + MO_G), *Bg = (float*)(ws + WS_MISC + MO_BETA), *EG = (float*)(ws + WS_MISC + MO_EG), *LAMB = (float*)(ws + WS_MISC + MO_LAMB),
          *LAM32 = (float*)(ws + WS_MISC + MO_LAM32), *BBAR = (float*)(ws + WS_MISC + MO_BBAR);
    bf16 *XB = (bf16*)(ws + WS_XB), *X1B = (bf16*)(ws + WS_XB), *MIXA = (bf16*)(ws + WS_MIXA), *KMAT = (bf16*)(ws + WS_KMAT), *EPOW = (bf16*)(ws + WS_EPOW), *CPOW = (bf16*)(ws + WS_CPOW);
    bf16 *PROJ = (bf16*)(ws + WS_PROJ), *HB = (bf16*)(ws + WS_H), *NW = (bf16*)(ws + WS_NW), *QG = (bf16*)(ws + WS_QG), *KDT = (bf16*)(ws + WS_KDT), *QK = (bf16*)(ws + WS_QK);
    float* UT = (float*)(ws + WS_XB);

#if (PHASES >> 0) & 1
    {
        LAS float* scr = (LAS float*)(lds + wave * 16384);
        constexpr int I_WI = 16 * 80, I_GLU = 8 * 16, I_WO = 16 * 32, I_W1 = 16 * 128, I_W2 = 64 * 32, NIT = I_WI + I_GLU + I_WO + I_W1 + I_W2;
        for (int it = gw; it < NIT; it += NGW) {
            int r = it;
            if (r < I_WI) { p0_tr_item(w_in, 2568, 1024, 80, WI_t, scr, r, lane, 1); continue; } r -= I_WI;
            if (r < I_GLU) { p0_tr_item(w_glu, 512, 512, 16, WGLU_t, scr, r, lane, 0); continue; } r -= I_GLU;
            if (r < I_WO) { p0_tr_item(w_out, 1024, 1024, 32, WO_t, scr, r, lane, 0); continue; } r -= I_WO;
            if (r < I_W1) { p0_tr_item(w_ff1, 4096, 1024, 128, W1_t, scr, r, lane, 0); continue; } r -= I_W1;
            p0_tr_item(w_ff2, 1024, 4096, 32, W2_t, scr, r, lane, 0);
        }
        __syncthreads();
        LAS float* wg = (LAS float*)lds;
        for (int idx = tid; idx < 8192; idx += 512) { const int k = idx >> 3, c = idx & 7; wg[c * 1024 + k] = w_in[(size_t)k * 2568 + 2048 + c]; }
        __syncthreads();
        for (int m = gw; m < MPAD; m += NGW) {
            v2u* o8 = (v2u*)(XB + (size_t)m * 1024) + lane;
            if (m >= MR) {
#pragma unroll
                for (int j = 0; j < 4; ++j) o8[64 * j] = (v2u){0u, 0u};
                continue; }
            const f32x4* xr = (const f32x4*)(m < MP ? xP + (size_t)m * 1024 : xS + (size_t)(m - MP) * 1024) + lane;
            f32x4 v[4];
#pragma unroll
            for (int j = 0; j < 4; ++j) { v[j] = xr[64 * j]; v2u w; w.x = pk2(v[j].x, v[j].y); w.y = pk2(v[j].z, v[j].w); o8[64 * j] = w; }
            float d[8];
#pragma unroll
            for (int c = 0; c < 8; ++c) { float s = 0.f;
#pragma unroll
                for (int j = 0; j < 4; ++j) { const f32x4 w = *(const LAS f32x4*)(wg + c * 1024 + 256 * j + 4 * lane); s += v[j].x * w.x + v[j].y * w.y + v[j].z * w.z + v[j].w * w.w; }
                d[c] = wave_sum(s); }
            if (lane == 0) { f32x4 bt, gv;
#pragma unroll
                for (int hq = 0; hq < 4; ++hq) { bt[hq] = sigmf_(d[hq]); const float xx = d[4 + hq] + dt_bias[hq]; const float sp = xx > 20.f ? xx : log1pf(__expf(xx)); gv[hq] = -__expf(a_log[hq]) * sp; }
                *(f32x4*)(Bg + (size_t)m * 4) = bt; *(f32x4*)(Gg + (size_t)m * 4) = gv; }
        }
        __syncthreads();
        for (int job = bid; job < 256; job += G) {
            const int g = job >> 3, part = job & 7;
            LAS float* PW = (LAS float*)lds;
            LAS float* BB = PW + 4224;
            LAS float* CC = BB + 2048;
            LAS float* KL = CC + 2048;
            const float dt = __expf(s5ldt[g]);
            for (int idx = tid; idx < 33 * 64; idx += 512) { const int n = idx >> 6, p = idx & 63; const float are = s5are[g * 64 + p], aim = s5aim[g * 64 + p];
                const float mag = expf((float)n * are * dt); float sn, cs; sincosf((float)n * aim * dt, &sn, &cs); PW[idx * 2] = mag * cs; PW[idx * 2 + 1] = mag * sn; }
            for (int idx = tid; idx < 1024; idx += 512) { const int p = idx >> 4, c = idx & 15; const float are = s5are[g * 64 + p], aim = s5aim[g * 64 + p];
                const float mag = expf(are * dt); float sn, cs; sincosf(aim * dt, &sn, &cs); const float lr = mag * cs - 1.f, li = mag * sn; const float den = are * are + aim * aim;
                const float fr_ = (lr * are + li * aim) / den, fi_ = (li * are - lr * aim) / den;
                const float br = s5bre[(size_t)(g * 64 + p) * 16 + c], bi = s5bim[(size_t)(g * 64 + p) * 16 + c];
                const float vr = fr_ * br - fi_ * bi, vi = fr_ * bi + fi_ * br; BB[idx * 2] = vr; BB[idx * 2 + 1] = vi;
                if (part == 0) { BBAR[((size_t)(g * 64 + p) * 16 + c) * 2] = vr; BBAR[((size_t)(g * 64 + p) * 16 + c) * 2 + 1] = vi; } }
            for (int idx = tid; idx < 1024; idx += 512) { CC[idx * 2] = s5cre[(size_t)g * 1024 + idx]; CC[idx * 2 + 1] = s5cim[(size_t)g * 1024 + idx]; }
            if (part == 0 && tid < 64) { const float are = s5are[g * 64 + tid], aim = s5aim[g * 64 + tid]; float sn, cs;
                float mag = expf(are * dt); sincosf(aim * dt, &sn, &cs); LAMB[(g * 64 + tid) * 2] = mag * cs; LAMB[(g * 64 + tid) * 2 + 1] = mag * sn;
                mag = expf(32.f * are * dt); sincosf(32.f * aim * dt, &sn, &cs); LAM32[(g * 64 + tid) * 2] = mag * cs; LAM32[(g * 64 + tid) * 2 + 1] = mag * sn; }
            __syncthreads();
            for (int rr = 0; rr < 2; ++rr) { const int idx = tid + 512 * rr, dd = idx >> 8, c = (idx >> 4) & 15, c2 = idx & 15, d = 4 * part + dd;
                float s = 0.f;
                for (int p = 0; p < 64; ++p) { const float pr = PW[(d * 64 + p) * 2], pi = PW[(d * 64 + p) * 2 + 1], br = BB[(p * 16 + c2) * 2], bi = BB[(p * 16 + c2) * 2 + 1];
                    const float zr = pr * br - pi * bi, zi = pr * bi + pi * br; s += CC[(c * 64 + p) * 2] * zr - CC[(c * 64 + p) * 2 + 1] * zi; }
                KL[idx] = s; }
            __syncthreads();
            bf16* KM = KMAT + (size_t)g * 262144;
            for (int u = tid; u < 4096; u += 512) { const int dd = u >> 10, rem = u & 1023, t = rem >> 5, c = (rem >> 1) & 15, hq = rem & 1, d = 4 * part + dd;
                const int s = t - d;
                if (s >= 0) { const LAS float* kl = KL + dd * 256 + c * 16 + 8 * hq; v4u o; o.x = pk2(kl[0], kl[1]); o.y = pk2(kl[2], kl[3]); o.z = pk2(kl[4], kl[5]); o.w = pk2(kl[6], kl[7]);
                    *(v4u*)(KM + ((size_t)((t >> 1) * 32 + s) * 64 + hq * 32 + 16 * (t & 1) + c) * 8) = o; }
                const int s2 = t + d;
                if (d >= 1 && s2 < 32) *(v4u*)(KM + ((size_t)((t >> 1) * 32 + s2) * 64 + hq * 32 + 16 * (t & 1) + c) * 8) = (v4u){0u, 0u, 0u, 0u}; }
            bf16* EP = EPOW + (size_t)g * 65536;
            for (int u = tid; u < 1024; u += 512) { const int q = u >> 3, sdd = (u >> 1) & 3, hq = u & 1, s = 4 * part + sdd, p = q & 63, im = q >> 6, n = 31 - s;
                const float pr = PW[(n * 64 + p) * 2], pi = PW[(n * 64 + p) * 2 + 1]; float v[8];
#pragma unroll
                for (int j = 0; j < 8; ++j) { const float br = BB[(p * 16 + 8 * hq + j) * 2], bi = BB[(p * 16 + 8 * hq + j) * 2 + 1]; v[j] = im ? (pr * bi + pi * br) : (pr * br - pi * bi); }
                v4u o; o.x = pk2(v[0], v[1]); o.y = pk2(v[2], v[3]); o.z = pk2(v[4], v[5]); o.w = pk2(v[6], v[7]);
                *(v4u*)(EP + ((size_t)((q >> 5) * 32 + s) * 64 + hq * 32 + (q & 31)) * 8) = o; }
            bf16* CP = CPOW + (size_t)g * 65536;
            for (int u = tid; u < 1024; u += 512) { const int tdd = u >> 8, c = (u >> 4) & 15, q8 = u & 15, t = 4 * part + tdd, n = t + 1; float v[8];
#pragma unroll
                for (int j = 0; j < 8; ++j) { const int q = 8 * q8 + j, p = q & 63, im = q >> 6; const float pr = PW[(n * 64 + p) * 2], pi = PW[(n * 64 + p) * 2 + 1], cr = CC[(c * 64 + p) * 2], ci = CC[(c * 64 + p) * 2 + 1];
                    const float zr = cr * pr - ci * pi, zi = cr * pi + ci * pr; v[j] = im ? -zi : zr; }
                v4u o; o.x = pk2(v[0], v[1]); o.y = pk2(v[2], v[3]); o.z = pk2(v[4], v[5]); o.w = pk2(v[6], v[7]);
                *(v4u*)(CP + ((size_t)(((t >> 1) * 8 + (q8 >> 1)) * 64) + (q8 & 1) * 32 + 16 * (t & 1) + c) * 8) = o; }
            __syncthreads();
        }
    }
    grid.sync();

#endif
#if (PHASES >> 1) & 1
    { pg8::Gemm g{XB, WI_t, MPAD, NPJ, 1024, 1024}; pg8::StaticOrder S; S.init(MPAD, NPJ, G, bid);
      pg8::EpiBf16<0> E{PROJ, NPJ, nullptr, 0, 0, 1.f};
      pg8::gemm_phase<pg8::EpiBf16<0>, pg8::StaticOrder, true, true>(lds, g, S, E); }
    grid.sync();

#endif
#if (PHASES >> 2) & 1
#if P2SEL & 1
    for (int unit = bid; unit < 1024; unit += G) gdn_g1_unit(lds, unit, PROJ, w_conv, Gg, Bg, UT, NW, QG, KDT, QK, EG, tid, lane, wave);
    for (int idx = bid * 512 + tid; idx < 36864; idx += G * 512) { const int b = idx / 4608, rem = idx % 4608, r = rem / 1536, ch = rem % 1536;
        out[OUT_CONV_P + idx] = bf2f(PROJ[(size_t)(b * TSEQ + 2045 + r) * NPJ + ch]); }
#endif
#if P2SEL & 2
    for (int unit = bid; unit < 256; unit += G) s5_prompt_unit(lds, unit, PROJ, KMAT, EPOW, CPOW, LAM32, s5d, out + OUT_RE_P, out + OUT_IM_P, tid, lane, wave);
#endif
#if P2SEL & 4
    for (int task = bid; task < 512; task += G) gdn_sample_task(lds, task, PROJ, w_conv, sconv, sgdn, Gg, Bg, out + OUT_GDN_S, out + OUT_CONV_S, tid, lane, wave);
#endif
#if P2SEL & 8
    for (int task = gw; task < 4096; task += NGW) s5_sample_task(task, PROJ, LAMB, BBAR, s5cre, s5cim, s5d, sre, sim, out + OUT_RE_S, out + OUT_IM_S, lane);
#endif
    grid.sync();

#endif
#if (PHASES >> 3) & 1
    for (int unit = bid; unit < 256; unit += G) gdn_g2_unit(lds, unit, PROJ, UT, NW, QG, KDT, QK, EG, out + OUT_GDN_P, tid, lane, wave);
    grid.sync();

#endif
#if (PHASES >> 4) & 1
    for (int m = gw; m < MPAD; m += NGW) {
        v4u* op = (v4u*)(MIXA + (size_t)m * 1024) + lane;
        if (m >= MR) { *op = (v4u){0u, 0u, 0u, 0u}; continue; }
        const v4u o8 = *((const v4u*)(PROJ + (size_t)m * NPJ + CQ) + lane), z8 = *((const v4u*)(PROJ + (size_t)m * NPJ + CZ) + lane);
        float o[8], z[8];
#pragma unroll
        for (int q = 0; q < 4; ++q) { o[2 * q] = bflo(o8[q]); o[2 * q + 1] = bfhi(o8[q]); z[2 * q] = bflo(z8[q]); z[2 * q + 1] = bfhi(z8[q]); }
        float ss = 0.f;
#pragma unroll
        for (int q = 0; q < 8; ++q) ss += o[q] * o[q];
        ss += __shfl_xor(ss, 1); ss += __shfl_xor(ss, 2); ss += __shfl_xor(ss, 4); ss += __shfl_xor(ss, 8);
        const float rn = rsqrtf(ss * (1.f / 128.f) + EPS);
        const f32x4 n0 = *(const f32x4*)(norm_w + ((8 * lane) & 127)), n1 = *(const f32x4*)(norm_w + ((8 * lane) & 127) + 4);
        float r[8];
#pragma unroll
        for (int q = 0; q < 4; ++q) { r[q] = o[q] * rn * n0[q] * siluf_(z[q]); r[4 + q] = o[4 + q] * rn * n1[q] * siluf_(z[4 + q]); }
        v4u w; w.x = pk2(r[0], r[1]); w.y = pk2(r[2], r[3]); w.z = pk2(r[4], r[5]); w.w = pk2(r[6], r[7]); *op = w;
    }
    { pg8::Gemm g{PROJ + CU, WGLU_t, MPAD, 512, 512, NPJ}; pg8::StaticOrder S; S.init(MPAD, 512, G, bid);
      pg8::EpiGlu E{MIXA, 1024, 512, PROJ, NPJ, CU, b_glu};
      pg8::gemm_phase<pg8::EpiGlu, pg8::StaticOrder, true, true>(lds, g, S, E); }
    grid.sync();

#endif
#if (PHASES >> 5) & 1
    { pg8::Gemm g{MIXA, WO_t, MPAD, 1024, 1024, 1024}; pg8::StaticOrder S; S.init(MPAD, 1024, G, bid);
      pg8::EpiResF32 E{xP, xS, out, DN_ALPHA, MP, MR};
      pg8::gemm_phase<pg8::EpiResF32, pg8::StaticOrder, true, true>(lds, g, S, E); }
    grid.sync();
    for (int m = gw; m < MPAD; m += NGW) {
        if (m >= MR) { v2u* o8 = (v2u*)(X1B + (size_t)m * 1024) + lane;
#pragma unroll
            for (int j = 0; j < 4; ++j) o8[64 * j] = (v2u){0u, 0u};
            continue; }
        ln_row(out + (size_t)m * 1024, ln1g, ln1b, X1B + (size_t)m * 1024, lane);
    }
    grid.sync();

#endif
#if (PHASES >> 6) & 1
    { pg8::Gemm g{X1B, W1_t, MPAD, DFF, 1024, 1024}; pg8::StaticOrder S; S.init(MPAD, DFF, G, bid);
      pg8::EpiRelu2 E{HB, DFF};
      pg8::gemm_phase<pg8::EpiRelu2, pg8::StaticOrder, true, true>(lds, g, S, E); }
    grid.sync();

#endif
#if (PHASES >> 7) & 1
    { pg8::Gemm g{HB, W2_t, MPAD, 1024, DFF, DFF}; pg8::StaticOrder S; S.init(MPAD, 1024, G, bid);
      pg8::EpiResF32 E{out, out + (size_t)MP * 1024, out, DN_ALPHA, MP, MR};
      pg8::gemm_phase<pg8::EpiResF32, pg8::StaticOrder, true, true>(lds, g, S, E); }
    grid.sync();
    for (int m = gw; m < MR; m += NGW) ln_row(out + (size_t)m * 1024, ln2g, ln2b, nullptr, lane);
#endif
}

extern "C" void kernel_launch(void* const* d_in, const int* in_sizes, int n_in, void* d_out, int out_size, void* d_ws, size_t ws_size, hipStream_t stream) {
    static int grid = 0;
    if (grid == 0) {
        if (n_in != 28 || (size_t)out_size != OUT_TOTAL || ws_size < WS_END) { fprintf(stderr, "kernel_launch: unexpected shapes (n_in %d out %d ws %zu)\n", n_in, out_size, ws_size); grid = -1; return; }
        int dev = 0, cus = 0, per_cu = 0;
        hipGetDevice(&dev); hipDeviceGetAttribute(&cus, hipDeviceAttributeMultiprocessorCount, dev);
        if (hipFuncSetAttribute((const void*)hymba_fwd, hipFuncAttributeMaxDynamicSharedMemorySize, LDS_BYTES) != hipSuccess) { fprintf(stderr, "kernel_launch: hipFuncSetAttribute failed\n"); grid = -1; return; }
        if (hipOccupancyMaxActiveBlocksPerMultiprocessor(&per_cu, (const void*)hymba_fwd, 512, LDS_BYTES) != hipSuccess || per_cu < 1) { fprintf(stderr, "kernel_launch: occupancy query says %d\n", per_cu); per_cu = 1; }
        (void)hipGetLastError();
        grid = cus;
    }
    if (grid < 0) return;
    Args a{};
    for (int i = 0; i < 28; ++i) a.in[i] = (const float*)d_in[i];
    a.out = (float*)d_out; a.ws = (unsigned char*)d_ws;
    void* args[] = {&a};
    hipError_t e = hipLaunchCooperativeKernel((const void*)hymba_fwd, dim3(grid), dim3(512), args, LDS_BYTES, stream);
    if (e != hipSuccess) fprintf(stderr, "cooperative launch failed: %s (grid %d)\n", hipGetErrorString(e), grid);
}
```

```cpp
#include <hip/hip_runtime.h>
#include <hip/hip_cooperative_groups.h>
#include <cstdio>
#include <cstdint>
namespace cg = cooperative_groups;
namespace pg8 {
#define PG8_LAS __attribute__((address_space(3)))
typedef unsigned short bf16_t;
typedef short bf16x8 __attribute__((ext_vector_type(8)));
typedef float f32x4 __attribute__((ext_vector_type(4)));
typedef unsigned u32x4 __attribute__((ext_vector_type(4)));
constexpr int BM = 256, BK = 64, HALF = 128, HTB = HALF * BK * 2  , STAGE_BYTES = 8 * HTB, NXCD = 8, WGM = 8;

__host__ __device__ __forceinline__ int lds_byte(int r, int c) { const int st = (r >> 4) * 2 + (c >> 5), rr = r & 15, cc = c & 31, ob = rr * 64 + cc * 2; return st * 1024 + (ob ^ (((ob >> 9) & 1) << 5)); }
__host__ __device__ __forceinline__ void stage_rc(int b, int& R, int& C) { const int st = b / 1024, sb = b % 1024, swz = sb ^ (((sb >> 9) & 1) << 5); R = (st >> 1) * 16 + swz / 64; C = (st & 1) * 32 + (swz % 64) / 2; }
__host__ __device__ __forceinline__ int perm32(int rho) { const int n = rho >> 4, i = rho & 15; return 8 * (i >> 2) + 4 * n + (i & 3); }

struct Unit { int pm, pn; };
struct Gemm { const bf16_t* A; const bf16_t* Bt; int M, N, K, lda; };

struct StaticOrder {
    int nM, nN, nwg, G, c;
    __host__ __device__ void init(int M, int N, int G_, int c_) { nM = M / BM; nN = N / BM; nwg = nM * nN; G = G_; c = c_; }
    __host__ __device__ bool next(int i, Unit& u) const {
        const long L = (long)i * G + c; if (L >= nwg) return false;
        int wgid = (int)L; { const int q = nwg / NXCD, r = nwg % NXCD, xcd = wgid % NXCD, off = wgid / NXCD; wgid = (xcd < r ? xcd * (q + 1) : r * (q + 1) + (xcd - r) * q) + off; }
        const int nig = WGM * nN, gid = wgid / nig, fm = gid * WGM, gsz = (nM - fm) < WGM ? (nM - fm) : WGM;
        u.pm = fm + ((wgid % nig) % gsz); u.pn = (wgid % nig) / gsz; return true;
    }
    __device__ __forceinline__ void a_ready(const Unit&) const {}
    __device__ __forceinline__ void done(const Unit&) const {}
};

__device__ __forceinline__ unsigned cvt_pk_bf16(float lo, float hi) { unsigned r; asm volatile("v_cvt_pk_bf16_f32 %0, %1, %2" : "=v"(r) : "v"(lo), "v"(hi)); return r; }
typedef float f32x2 __attribute__((ext_vector_type(2)));
__device__ __forceinline__ f32x2 gelu_pk(f32x2 v) {
    const f32x2 av = __builtin_elementwise_abs(v), d = av * 0.2316418882f + 1.0f;
    f32x2 t; t.x = __builtin_amdgcn_rcpf(d.x); t.y = __builtin_amdgcn_rcpf(d.y);
    f32x2 q = t * 0.5307027145f + (-0.7265760135f); q = q * t + 0.7107068705f; q = q * t + (-0.142248368f); q = q * t + 0.127414796f; q = q * t;
    const f32x2 s = (v * v) * (-0.72134752044f);
    f32x2 e; e.x = __builtin_amdgcn_exp2f(s.x); e.y = __builtin_amdgcn_exp2f(s.y);
    const f32x2 m = v * (q * e), r = v - m;
    f32x2 o; o.x = v.x < 0.f ? m.x : r.x; o.y = v.y < 0.f ? m.y : r.y; return o;
}

template <int ACT  > struct EpiBf16 {
    static constexpr bool PERM = true, AFTER_DRAIN = false; static_assert(ACT == 0 || ACT == 1, "EpiBf16: ACT is 0 (none) or 1 (gelu_pk)");
    bf16_t* O; int ldc; const float* bias; int split_cols; size_t split_stride; float scale0;
    __device__ __forceinline__ void operator()(const f32x4 (&acc)[2][2][4][2], const Unit& u, int wr, int wc, int fr, int fq) const {
        const int row0 = u.pm * BM + wr * 64 + fr; int colt = u.pn * BM; bf16_t* base = O;
        float sc = 1.f; if (split_cols) { const int t = colt / split_cols; base += (size_t)t * split_stride; colt -= t * split_cols; if (t == 0) sc = scale0; }
        const int col0 = colt + wc * 32 + 8 * fq, bcol0 = u.pn * BM + wc * 32 + 8 * fq;
        f32x4 bv[2][2];
#pragma unroll
        for (int bj = 0; bj < 2; ++bj)
#pragma unroll
            for (int n = 0; n < 2; ++n) bv[bj][n] = bias ? *(const f32x4*)(bias + bcol0 + bj * HALF + 4 * n) : (f32x4){0.f, 0.f, 0.f, 0.f};
#pragma unroll
        for (int ai = 0; ai < 2; ++ai)
#pragma unroll
            for (int m = 0; m < 4; ++m) { bf16_t* rowp = base + (size_t)(row0 + ai * HALF + m * 16) * ldc + col0;
#pragma unroll
                for (int bj = 0; bj < 2; ++bj) { f32x4 v0 = acc[ai][bj][m][0] + bv[bj][0], v1 = acc[ai][bj][m][1] + bv[bj][1];
                    if (ACT == 1) { f32x2 a = gelu_pk((f32x2){v0[0], v0[1]}), b = gelu_pk((f32x2){v0[2], v0[3]}), c = gelu_pk((f32x2){v1[0], v1[1]}), d = gelu_pk((f32x2){v1[2], v1[3]});
                        v0 = (f32x4){a.x, a.y, b.x, b.y}; v1 = (f32x4){c.x, c.y, d.x, d.y}; }
                    v0 = v0 * sc; v1 = v1 * sc; u32x4 w; w.x = cvt_pk_bf16(v0[0], v0[1]); w.y = cvt_pk_bf16(v0[2], v0[3]); w.z = cvt_pk_bf16(v1[0], v1[1]); w.w = cvt_pk_bf16(v1[2], v1[3]);
                    *(u32x4*)(rowp + bj * HALF) = w; } }
    }
};
struct EpiGlu {
    static constexpr bool PERM = true, AFTER_DRAIN = false;
    bf16_t* O; int ldo, ocol0; const bf16_t* Y; int ldy, ycol0; const float* bias;
    __device__ __forceinline__ void operator()(const f32x4 (&acc)[2][2][4][2], const Unit& u, int wr, int wc, int fr, int fq) const {
        const int row0 = u.pm * BM + wr * 64 + fr, col0 = u.pn * BM + wc * 32 + 8 * fq;
#pragma unroll
        for (int ai = 0; ai < 2; ++ai)
#pragma unroll
            for (int m = 0; m < 4; ++m) { const size_t row = (size_t)(row0 + ai * HALF + m * 16);
#pragma unroll
                for (int bj = 0; bj < 2; ++bj) { const int col = col0 + bj * HALF;
                    const f32x4 b0 = *(const f32x4*)(bias + col), b1 = *(const f32x4*)(bias + col + 4);
                    const u32x4 yv = *(const u32x4*)(Y + row * ldy + ycol0 + col);
                    const f32x4 v0 = acc[ai][bj][m][0] + b0, v1 = acc[ai][bj][m][1] + b1;
                    float y[8], o[8];
#pragma unroll
                    for (int q = 0; q < 4; ++q) { y[2 * q] = __uint_as_float(yv[q] << 16); y[2 * q + 1] = __uint_as_float(yv[q] & 0xffff0000u); }
#pragma unroll
                    for (int q = 0; q < 4; ++q) { o[q] = y[q] / (1.f + __expf(-v0[q])); o[4 + q] = y[4 + q] / (1.f + __expf(-v1[q])); }
                    u32x4 w; w.x = cvt_pk_bf16(o[0], o[1]); w.y = cvt_pk_bf16(o[2], o[3]); w.z = cvt_pk_bf16(o[4], o[5]); w.w = cvt_pk_bf16(o[6], o[7]);
                    *(u32x4*)(O + row * ldo + ocol0 + col) = w; } }
    }
};
struct EpiRelu2 {
    static constexpr bool PERM = true, AFTER_DRAIN = false;
    bf16_t* O; int ldc;
    __device__ __forceinline__ void operator()(const f32x4 (&acc)[2][2][4][2], const Unit& u, int wr, int wc, int fr, int fq) const {
        const int row0 = u.pm * BM + wr * 64 + fr, col0 = u.pn * BM + wc * 32 + 8 * fq;
#pragma unroll
        for (int ai = 0; ai < 2; ++ai)
#pragma unroll
            for (int m = 0; m < 4; ++m) { bf16_t* rowp = O + (size_t)(row0 + ai * HALF + m * 16) * ldc + col0;
#pragma unroll
                for (int bj = 0; bj < 2; ++bj) { f32x4 v0 = acc[ai][bj][m][0], v1 = acc[ai][bj][m][1];
#pragma unroll
                    for (int q = 0; q < 4; ++q) { const float a = fmaxf(v0[q], 0.f), b = fmaxf(v1[q], 0.f); v0[q] = a * a; v1[q] = b * b; }
                    u32x4 w; w.x = cvt_pk_bf16(v0[0], v0[1]); w.y = cvt_pk_bf16(v0[2], v0[3]); w.z = cvt_pk_bf16(v1[0], v1[1]); w.w = cvt_pk_bf16(v1[2], v1[3]);
                    *(u32x4*)(rowp + bj * HALF) = w; } }
    }
};
struct EpiResF32 {
    static constexpr bool PERM = false, AFTER_DRAIN = false;
    const float* resP; const float* resS; float* out; float alpha; int split, nrows;
    __device__ __forceinline__ void operator()(const f32x4 (&acc)[2][2][4][2], const Unit& u, int wr, int wc, int fr, int fq) const {
        const int row0 = u.pm * BM + wr * 64 + fr, col0 = u.pn * BM + wc * 32 + 4 * fq;
#pragma unroll
        for (int ai = 0; ai < 2; ++ai)
#pragma unroll
            for (int m = 0; m < 4; ++m) { const int row = row0 + ai * HALF + m * 16;
                if (row < nrows) {
                    const float* rp = (row < split ? resP + (size_t)row * 1024 : resS + (size_t)(row - split) * 1024) + col0;
                    float* op = out + (size_t)row * 1024 + col0;
#pragma unroll
                    for (int bj = 0; bj < 2; ++bj)
#pragma unroll
                        for (int n = 0; n < 2; ++n) { const f32x4 r = *(const f32x4*)(rp + bj * HALF + n * 16); *(f32x4*)(op + bj * HALF + n * 16) = r * alpha + acc[ai][bj][m][n]; }
                } }
    }
};
template <class Epi, class Sched, bool ALIGN_EPI = false, bool SP2 = false>
__device__ __forceinline__ void gemm_phase(PG8_LAS unsigned char* lds, const Gemm g, const Sched& S, const Epi& E) {
    const int tid = threadIdx.x, wid = __builtin_amdgcn_readfirstlane(tid >> 6), lane = tid & 63, wr = wid >> 2, wc = wid & 3, fr = lane & 15, fq = lane >> 4;
    const int K = g.K, nt = K / BK;
    unsigned voffA[2], voffB[2];
#pragma unroll
    for (int i = 0; i < 2; ++i) { int R, C; stage_rc(tid * 16 + i * 8192, R, C); const int Rb = Epi::PERM ? ((R & ~31) + perm32(R & 31)) : R;
        voffA[i] = (unsigned)(R * g.lda + C) * 2u; voffB[i] = (unsigned)(Rb * K + C) * 2u; }
    const size_t kstep = (size_t)(BK * 2);
    const size_t hstepA = (size_t)HALF * g.lda * 2, hstepB = (size_t)HALF * K * 2;
    const size_t tstepA = 2 * hstepA, tstepB = 2 * hstepB;
    const unsigned ldsw = (unsigned)wid * 1024u;
    const int aoff = lds_byte(wr * 64 + fr, fq * 8), boff = lds_byte(wc * 32 + fr, fq * 8);
#define PG8_SA(b, h) (((b) * 2 + (h)) * HTB)
#define PG8_SB(b, h) ((4 + (b) * 2 + (h)) * HTB)
#define PG8_STAGE(bufoff, gbase, voff) do { _Pragma("unroll") for (int _i = 0; _i < 2; ++_i) \
        __builtin_amdgcn_global_load_lds((const unsigned*)((const char*)(gbase) + (voff)[_i]), (PG8_LAS unsigned*)(lds + (bufoff) + ldsw + _i * 8192), 16, 0, 0); } while (0)
#define PG8_LDA(dst, b, h) do { _Pragma("unroll") for (int m = 0; m < 4; ++m) _Pragma("unroll") for (int k = 0; k < 2; ++k) dst[m][k] = *(const PG8_LAS bf16x8*)(lds + PG8_SA(b, h) + aoff + m * 2048 + k * 1024); } while (0)
#define PG8_LDB(dst, b, h) do { _Pragma("unroll") for (int n = 0; n < 2; ++n) _Pragma("unroll") for (int k = 0; k < 2; ++k) dst[n][k] = *(const PG8_LAS bf16x8*)(lds + PG8_SB(b, h) + boff + n * 2048 + k * 1024); } while (0)
#define PG8_MMA(ai, bj, At, Bt) do { __builtin_amdgcn_s_setprio(1); _Pragma("unroll") for (int m = 0; m < 4; ++m) _Pragma("unroll") for (int n = 0; n < 2; ++n) _Pragma("unroll") for (int k = 0; k < 2; ++k) \
        acc[ai][bj][m][n] = __builtin_amdgcn_mfma_f32_16x16x32_bf16(Bt[n][k], At[m][k], acc[ai][bj][m][n], 0, 0, 0); __builtin_amdgcn_s_setprio(0); } while (0)
#define PG8_WAIT_V(n) asm volatile("s_waitcnt vmcnt(" #n ")" ::: "memory")
#define PG8_WAIT_L(n) asm volatile("s_waitcnt lgkmcnt(" #n ")" ::: "memory")
#define PG8_BAR __builtin_amdgcn_s_barrier()
#define PG8_SCHED __builtin_amdgcn_sched_barrier(0)
    Unit cur, nxt; int ui = 0;
    if (!S.next(0, cur)) return;
    f32x4 acc[2][2][4][2];
#pragma unroll
    for (int a = 0; a < 2; ++a)
#pragma unroll
        for (int b = 0; b < 2; ++b)
#pragma unroll
            for (int m = 0; m < 4; ++m)
#pragma unroll
                for (int n = 0; n < 2; ++n) acc[a][b][m][n] = (f32x4){0.f, 0.f, 0.f, 0.f};
    bf16x8 At[4][2], B0[2][2], B1[2][2];
    const char* cA = (const char*)g.A + (size_t)cur.pm * tstepA; const char* cB = (const char*)g.Bt + (size_t)cur.pn * tstepB;
    S.a_ready(cur);
    if constexpr (SP2) {
        PG8_STAGE(PG8_SB(0, 0), cB, voffB); PG8_STAGE(PG8_SB(0, 1), cB + hstepB, voffB); PG8_STAGE(PG8_SA(0, 0), cA, voffA); PG8_STAGE(PG8_SA(0, 1), cA + hstepA, voffA);
        if (wr == 1) PG8_BAR;
        PG8_WAIT_V(2); PG8_BAR;
        PG8_STAGE(PG8_SB(1, 0), cB + kstep, voffB); PG8_STAGE(PG8_SA(1, 0), cA + kstep, voffA); PG8_STAGE(PG8_SB(1, 1), cB + hstepB + kstep, voffB);
        PG8_WAIT_V(6); PG8_BAR;
    } else {
        PG8_STAGE(PG8_SB(0, 0), cB, voffB); PG8_STAGE(PG8_SA(0, 0), cA, voffA); PG8_STAGE(PG8_SB(0, 1), cB + hstepB, voffB); PG8_STAGE(PG8_SA(0, 1), cA + hstepA, voffA);
        if (wr == 1) PG8_BAR;
        PG8_WAIT_V(4); PG8_BAR;
        PG8_STAGE(PG8_SB(1, 0), cB + kstep, voffB); PG8_STAGE(PG8_SA(1, 0), cA + kstep, voffA); PG8_STAGE(PG8_SB(1, 1), cB + hstepB + kstep, voffB);
        PG8_WAIT_V(6); PG8_BAR;
    }
    for (;;) {
        const bool has_next = S.next(ui + 1, nxt);
        const char* nA = has_next ? (const char*)g.A + (size_t)nxt.pm * tstepA : cA; const char* nB = has_next ? (const char*)g.Bt + (size_t)nxt.pn * tstepB : cB;
        for (int t = 0; t < nt; t += 2) {
            const bool last = (t == nt - 2);
            const char* a1 = cA + (size_t)(t + 1) * kstep;
            const char* a2 = last ? nA : cA + (size_t)(t + 2) * kstep; const char* b2 = last ? nB : cB + (size_t)(t + 2) * kstep;
            const char* a3 = a2 + kstep; const char* b3 = b2 + kstep;
            if (last && has_next) S.a_ready(nxt);
            if constexpr (SP2) {
            PG8_LDB(B0, 0, 0); PG8_LDB(B1, 0, 1); PG8_SCHED; PG8_LDA(At, 0, 0); PG8_STAGE(PG8_SA(1, 1), a1 + hstepA, voffA);
            PG8_WAIT_V(8); PG8_WAIT_L(0); PG8_BAR; PG8_MMA(0, 0, At, B0); PG8_MMA(0, 1, At, B1); PG8_BAR; PG8_SCHED;
            PG8_LDA(At, 0, 1); PG8_STAGE(PG8_SB(0, 0), b2, voffB); PG8_STAGE(PG8_SB(0, 1), b2 + hstepB, voffB); PG8_STAGE(PG8_SA(0, 0), a2, voffA);
            PG8_WAIT_V(8); PG8_WAIT_L(0); PG8_BAR; PG8_MMA(1, 0, At, B0); PG8_MMA(1, 1, At, B1); PG8_BAR; PG8_SCHED;
            PG8_LDB(B0, 1, 0); PG8_LDB(B1, 1, 1); PG8_SCHED; PG8_LDA(At, 1, 0); PG8_STAGE(PG8_SA(0, 1), a2 + hstepA, voffA);
            PG8_WAIT_V(8); PG8_WAIT_L(0); PG8_BAR; PG8_MMA(0, 0, At, B0); PG8_MMA(0, 1, At, B1); PG8_BAR; PG8_SCHED;
            PG8_LDA(At, 1, 1); PG8_STAGE(PG8_SB(1, 0), b3, voffB); PG8_STAGE(PG8_SB(1, 1), b3 + hstepB, voffB); PG8_STAGE(PG8_SA(1, 0), a3, voffA);
            PG8_WAIT_V(8); PG8_WAIT_L(0); PG8_BAR; PG8_MMA(1, 0, At, B0); PG8_MMA(1, 1, At, B1); PG8_BAR; PG8_SCHED;
            } else {
            PG8_LDB(B0, 0, 0); PG8_SCHED; PG8_LDA(At, 0, 0); PG8_STAGE(PG8_SA(1, 1), a1 + hstepA, voffA);
            PG8_WAIT_L(8); PG8_BAR; PG8_WAIT_L(0); PG8_MMA(0, 0, At, B0); PG8_BAR; PG8_SCHED;
            PG8_LDB(B1, 0, 1); PG8_STAGE(PG8_SB(0, 0), b2, voffB);
            PG8_BAR; PG8_WAIT_L(0); PG8_MMA(0, 1, At, B1); PG8_BAR;
            PG8_LDA(At, 0, 1); PG8_STAGE(PG8_SA(0, 0), a2, voffA);
            PG8_BAR; PG8_WAIT_L(0); PG8_MMA(1, 0, At, B0); PG8_BAR; PG8_SCHED;
            PG8_STAGE(PG8_SB(0, 1), b2 + hstepB, voffB);
            PG8_WAIT_V(6); PG8_BAR; PG8_MMA(1, 1, At, B1); PG8_BAR;
            PG8_LDB(B0, 1, 0); PG8_SCHED; PG8_LDA(At, 1, 0); PG8_STAGE(PG8_SA(0, 1), a2 + hstepA, voffA);
            PG8_WAIT_L(8); PG8_BAR; PG8_WAIT_L(0); PG8_MMA(0, 0, At, B0); PG8_BAR; PG8_SCHED;
            PG8_LDB(B1, 1, 1); PG8_STAGE(PG8_SB(1, 0), b3, voffB);
            PG8_BAR; PG8_WAIT_L(0); PG8_MMA(0, 1, At, B1); PG8_BAR;
            PG8_LDA(At, 1, 1); PG8_STAGE(PG8_SA(1, 0), a3, voffA);
            PG8_BAR; PG8_WAIT_L(0); PG8_MMA(1, 0, At, B0); PG8_BAR; PG8_SCHED;
            PG8_STAGE(PG8_SB(1, 1), b3 + hstepB, voffB);
            PG8_WAIT_V(6); PG8_BAR; PG8_MMA(1, 1, At, B1); PG8_BAR;
            }
        }
        if constexpr (ALIGN_EPI) { if (wr == 0) PG8_BAR; }
        if constexpr (!Epi::AFTER_DRAIN) { E(acc, cur, wr, wc, fr, fq); S.done(cur); }
        if (!has_next) break;
#pragma unroll
        for (int a = 0; a < 2; ++a)
#pragma unroll
            for (int b = 0; b < 2; ++b)
#pragma unroll
                for (int m = 0; m < 4; ++m)
#pragma unroll
                    for (int n = 0; n < 2; ++n) acc[a][b][m][n] = (f32x4){0.f, 0.f, 0.f, 0.f};
        cur = nxt; cA = nA; cB = nB; ++ui;
        if constexpr (ALIGN_EPI) { if (wr == 1) PG8_BAR; }
    }
    PG8_WAIT_V(0);
    if constexpr (!ALIGN_EPI) { if (wr == 0) PG8_BAR; }
    PG8_BAR;
    if constexpr (Epi::AFTER_DRAIN) { E.fused(acc, cur, wr, wc, fr, fq, lds, wid, lane); S.done(cur); }
#undef PG8_SA
#undef PG8_SB
#undef PG8_STAGE
#undef PG8_LDA
#undef PG8_LDB
#undef PG8_MMA
#undef PG8_WAIT_V
#undef PG8_WAIT_L
#undef PG8_BAR
#undef PG8_SCHED
}
}
#define GAS __attribute__((address_space(1)))
#define LAS __attribute__((address_space(3)))
typedef unsigned short bf16;
typedef unsigned v4u __attribute__((ext_vector_type(4)));
typedef unsigned v2u __attribute__((ext_vector_type(2)));
typedef float f32x4 __attribute__((ext_vector_type(4)));
typedef float f32x16 __attribute__((ext_vector_type(16)));
typedef short bf16x8 __attribute__((ext_vector_type(8)));
#define LDS_WAIT() asm volatile("s_waitcnt lgkmcnt(0)" ::: "memory")
#define WG_BAR() do { asm volatile("s_waitcnt lgkmcnt(0)" ::: "memory"); __builtin_amdgcn_s_barrier(); asm volatile("" ::: "memory"); } while (0)
#define MFMA32(a, b, c) __builtin_amdgcn_mfma_f32_32x32x16_bf16((a), (b), (c), 0, 0, 0)
#define MFMA16(a, b, c) __builtin_amdgcn_mfma_f32_16x16x32_bf16((a), (b), (c), 0, 0, 0)

constexpr int DM = 1024, TSEQ = 2048, MP = 16384, MR = 16512, MPAD = 16640, NPJ = 2560, DFF = 4096;
constexpr int CQ = 0, CK = 512, CV = 1024, CZ = 1536, CU = 2048;
constexpr float DN_ALPHA = 1.189207115002721f, EPS = 1e-6f, QSCALE = 0.08838834764831845f;
constexpr size_t MiB = 1u << 20;
constexpr size_t WS_WI = 1 * MiB, WS_WGLU = 6 * MiB, WS_WO = 6 * MiB + 512 * 1024, WS_W1 = 8 * MiB + 512 * 1024, WS_W2 = 16 * MiB + 512 * 1024;
constexpr size_t WS_MISC = 24 * MiB + 512 * 1024;
constexpr size_t MO_G = 0, MO_BETA = 278528, MO_EG = 557056, MO_LAMB = 573440, MO_LAM32 = 589824, MO_BBAR = 606208;
constexpr size_t WS_XB = 26 * MiB;
constexpr size_t WS_MIXA = 58 * MiB + 512 * 1024;
constexpr size_t WS_KMAT = WS_MIXA, WS_EPOW = WS_MIXA + 16 * MiB, WS_CPOW = WS_MIXA + 20 * MiB;
constexpr size_t WS_PROJ = 91 * MiB;
constexpr size_t WS_H = 91 * MiB;
constexpr size_t WS_NW = 172 * MiB + 512 * 1024, WS_QG = WS_NW + 16 * MiB, WS_KDT = WS_QG + 16 * MiB, WS_QK = WS_KDT + 16 * MiB;
constexpr size_t WS_END = 229 * MiB;
constexpr int LDS_BYTES = 147456;
constexpr size_t OUT_YS = 16777216, OUT_GDN_P = 16908288, OUT_CONV_P = 17432576, OUT_RE_P = 17469440, OUT_IM_P = 17485824,
                 OUT_GDN_S = 17502208, OUT_CONV_S = 25890816, OUT_RE_S = 26480640, OUT_IM_S = 26742784, OUT_TOTAL = 27004928;

__device__ __forceinline__ unsigned f2bf(float f) { unsigned u = __builtin_bit_cast(unsigned, f); return (u + 0x7fffu + ((u >> 16) & 1u)) >> 16; }
__device__ __forceinline__ unsigned pk2(float lo, float hi) { return f2bf(lo) | (f2bf(hi) << 16); }
__device__ __forceinline__ float bf2f(unsigned short b) { return __uint_as_float((unsigned)b << 16); }
__device__ __forceinline__ float bflo(unsigned w) { return __uint_as_float(w << 16); }
__device__ __forceinline__ float bfhi(unsigned w) { return __uint_as_float(w & 0xffff0000u); }
__device__ __forceinline__ float wave_sum(float v) {
#pragma unroll
    for (int o = 1; o < 64; o <<= 1) v += __shfl_xor(v, o);
    return v;
}
__device__ __forceinline__ float siluf_(float x) { return x / (1.f + __expf(-x)); }
__device__ __forceinline__ float sigmf_(float x) { return 1.f / (1.f + __expf(-x)); }
__device__ __forceinline__ float gelu_tanh(float y) { const float t = 0.7978845608028654f * (y + 0.044715f * y * y * y); const float th = 1.f - 2.f / (1.f + __expf(2.f * t)); return 0.5f * y * (1.f + th); }

__device__ __forceinline__ void p0_tr_item(const float* W, int ldw, int K, int nblk, bf16* WT, LAS float* scr, int item, int lane, int gate_skip) {
    const int kb = item / nblk, nb = item % nblk, k0 = 64 * kb, n0 = 32 * nb;
    const int sc0 = n0 + ((gate_skip && n0 >= 2048) ? 8 : 0);
#pragma unroll 8
    for (int i = 0; i < 32; ++i) { const int kk = 2 * i + (lane >> 5); scr[kk * 33 + (lane & 31)] = W[(size_t)(k0 + kk) * ldw + sc0 + (lane & 31)]; }
    LDS_WAIT();
    const int c = lane & 7;
#pragma unroll
    for (int j = 0; j < 4; ++j) { const int n = (lane >> 3) + 8 * j; const LAS float* s = scr + (8 * c) * 33 + n;
        v4u o; o.x = pk2(s[0 * 33], s[1 * 33]); o.y = pk2(s[2 * 33], s[3 * 33]); o.z = pk2(s[4 * 33], s[5 * 33]); o.w = pk2(s[6 * 33], s[7 * 33]);
        *(v4u*)(WT + (size_t)(n0 + n) * K + k0 + 8 * c) = o; }
    LDS_WAIT();
}

struct Args { const float* in[28]; float* out; unsigned char* ws; };
__device__ __forceinline__ void gdn_g1_unit(LAS unsigned char* lds, int unit, const bf16* PROJ, const float* wconv, const float* Gg, const float* Bg,
                                            float* UT, bf16* NW, bf16* QG, bf16* KDT, bf16* QK, float* EG, int tid, int lane, int wave) {
    const int b = unit >> 7, h = (unit >> 5) & 3, c = unit & 31;
    const int m0 = b * TSEQ + c * 64;
    LAS float* Vf = (LAS float*)lds;
    LAS unsigned char* KNb = lds + 65536;
    LAS unsigned char* QNb = lds + 65536 + 17408;
    LAS float* LM = (LAS float*)(lds + 65536 + 2 * 17408);
    LAS float* GC = (LAS float*)(lds + 65536 + 3 * 17408);
    LAS float* BT = GC + 64;
    LAS float* EX = GC + 128;
    if (tid < 384) {
        const int grp = tid >> 4, mat = grp >> 3, rs = grp & 7, cgm = tid & 15;
        const int col = mat * 512 + h * 128 + 8 * cgm;
        float w[4][8];
#pragma unroll
        for (int j = 0; j < 4; ++j) { const f32x4 a = *(const f32x4*)(wconv + j * 1536 + col), bq = *(const f32x4*)(wconv + j * 1536 + col + 4);
            w[j][0] = a.x; w[j][1] = a.y; w[j][2] = a.z; w[j][3] = a.w; w[j][4] = bq.x; w[j][5] = bq.y; w[j][6] = bq.z; w[j][7] = bq.w; }
        v4u raw[11];
#pragma unroll
        for (int q = 0; q < 11; ++q) { const int i = 8 * rs - 3 + q; const bool ok = (c > 0) || (i >= 0);
            raw[q] = (v4u){0u, 0u, 0u, 0u};
            if (ok) raw[q] = *(const v4u*)(PROJ + (size_t)(m0 + i) * NPJ + col); }
#pragma unroll
        for (int rr = 0; rr < 8; ++rr) {
            float y[8];
#pragma unroll
            for (int cc = 0; cc < 8; ++cc) { float a = 0.f;
#pragma unroll
                for (int j = 0; j < 4; ++j) { const unsigned wd = raw[rr + j][cc >> 1]; const float xv = (cc & 1) ? bfhi(wd) : bflo(wd); a += w[j][cc] * xv; }
                y[cc] = siluf_(a); }
            const int row = 8 * rs + rr;
            if (mat < 2) {
                float ss = 0.f;
#pragma unroll
                for (int cc = 0; cc < 8; ++cc) ss += y[cc] * y[cc];
                ss += __shfl_xor(ss, 1); ss += __shfl_xor(ss, 2); ss += __shfl_xor(ss, 4); ss += __shfl_xor(ss, 8);
                const float rn = rsqrtf(ss + EPS) * (mat == 0 ? QSCALE : 1.f);
                v4u o; o.x = pk2(y[0] * rn, y[1] * rn); o.y = pk2(y[2] * rn, y[3] * rn); o.z = pk2(y[4] * rn, y[5] * rn); o.w = pk2(y[6] * rn, y[7] * rn);
                *(LAS v4u*)((mat == 0 ? QNb : KNb) + row * 272 + cgm * 16) = o;
                if (mat == 1) { *(LAS f32x4*)(Vf + row * 256 + 128 + 8 * cgm) = (f32x4){y[0] * rn, y[1] * rn, y[2] * rn, y[3] * rn};
                                *(LAS f32x4*)(Vf + row * 256 + 128 + 8 * cgm + 4) = (f32x4){y[4] * rn, y[5] * rn, y[6] * rn, y[7] * rn}; }
            } else {
                *(LAS f32x4*)(Vf + row * 256 + 8 * cgm) = (f32x4){y[0], y[1], y[2], y[3]};
                *(LAS f32x4*)(Vf + row * 256 + 8 * cgm + 4) = (f32x4){y[4], y[5], y[6], y[7]};
            }
        }
    } else if (tid < 448) {
        float gl = Gg[(size_t)(m0 + lane) * 4 + h];
#pragma unroll
        for (int o = 1; o < 64; o <<= 1) { const float t = __shfl_up(gl, o); if (lane >= o) gl += t; }
        GC[lane] = gl; BT[lane] = Bg[(size_t)(m0 + lane) * 4 + h]; EX[lane] = __expf(gl) * BT[lane];
    }
    __syncthreads();
    {
        const int mat2 = wave >> 2, tile = wave & 3, ti = tile >> 1, tj = tile & 1;
        const int r = lane & 31, hh = lane >> 5;
        f32x16 acc;
#pragma unroll
        for (int i = 0; i < 16; ++i) acc[i] = 0.f;
        if (ti >= tj) {
            const LAS unsigned char* Ab = (mat2 == 0 ? KNb : QNb) + (32 * ti + r) * 272 + hh * 16;
            const LAS unsigned char* Bb = KNb + (32 * tj + r) * 272 + hh * 16;
#pragma unroll
            for (int ks = 0; ks < 8; ++ks) { const bf16x8 a = *(const LAS bf16x8*)(Ab + ks * 32), bq = *(const LAS bf16x8*)(Bb + ks * 32); acc = MFMA32(a, bq, acc); }
        }
        const int j = 32 * tj + r; const float gcj = GC[j];
        bf16* QKu = QK + (size_t)unit * 4096;
#pragma unroll
        for (int i16 = 0; i16 < 16; ++i16) { const int i = 32 * ti + (i16 & 3) + 8 * (i16 >> 2) + 4 * hh;
            const float dec = __expf(fminf(GC[i] - gcj, 0.f));
            if (mat2 == 0) LM[j * 68 + i] = (i > j) ? BT[i] * acc[i16] * dec : 0.f;
            else QKu[i * 64 + j] = (bf16)f2bf((i >= j) ? acc[i16] * dec : 0.f); }
    }
    __syncthreads();
    if (tid < 256) {
        const int col = tid; float x[64];
        int zo; asm volatile("v_mov_b32 %0, 0" : "=v"(zo));
        const LAS float* LTv = LM + zo;
        const LAS float* SCv = (col < 128 ? BT : EX) + zo;
#pragma unroll
        for (int i = 0; i < 64; ++i) { x[i] = Vf[i * 256 + col] * SCv[i]; if ((i & 7) == 7) { asm volatile("" ::: "memory"); __builtin_amdgcn_sched_barrier(0); } }
#pragma unroll
        for (int m = 0; m < 63; ++m) {
            const float xm = x[m];
#pragma unroll
            for (int q = (m + 1) >> 2; q < 16; ++q) { const f32x4 l = *(const LAS f32x4*)(LTv + m * 68 + 4 * q);
                if (4 * q + 0 > m) x[4 * q + 0] -= l.x * xm;
                if (4 * q + 1 > m) x[4 * q + 1] -= l.y * xm;
                if (4 * q + 2 > m) x[4 * q + 2] -= l.z * xm;
                if (4 * q + 3 > m) x[4 * q + 3] -= l.w * xm; }
            asm volatile("" ::: "memory"); __builtin_amdgcn_sched_barrier(0);
        }
        if (col < 128) { float* ut = UT + (size_t)unit * 8192 + col * 64;
#pragma unroll
            for (int q = 0; q < 16; ++q) *(f32x4*)(ut + 4 * q) = (f32x4){x[4 * q], x[4 * q + 1], x[4 * q + 2], x[4 * q + 3]};
        } else { bf16* nw = NW + (size_t)unit * 8192 + (col - 128);
#pragma unroll
            for (int i = 0; i < 64; ++i) nw[i * 128] = (bf16)f2bf(-x[i]); }
    } else {
        const int t2 = tid - 256; const float gl = GC[63];
        bf16* QGu = QG + (size_t)unit * 8192; bf16* KDu = KDT + (size_t)unit * 8192;
        for (int u = t2; u < 1024; u += 256) { const int i = u >> 4, d8 = u & 15; const v4u q = *(const LAS v4u*)(QNb + i * 272 + d8 * 16); const float e = __expf(GC[i]);
            v4u o; o.x = pk2(bflo(q.x) * e, bfhi(q.x) * e); o.y = pk2(bflo(q.y) * e, bfhi(q.y) * e); o.z = pk2(bflo(q.z) * e, bfhi(q.z) * e); o.w = pk2(bflo(q.w) * e, bfhi(q.w) * e);
            *(v4u*)(QGu + i * 128 + d8 * 8) = o; }
        for (int u = t2; u < 1024; u += 256) { const int d = u >> 3, i8 = u & 7; float v[8];
#pragma unroll
            for (int jj = 0; jj < 8; ++jj) { const int i = 8 * i8 + jj; v[jj] = bf2f(*(const LAS unsigned short*)(KNb + i * 272 + d * 2)) * __expf(gl - GC[i]); }
            v4u o; o.x = pk2(v[0], v[1]); o.y = pk2(v[2], v[3]); o.z = pk2(v[4], v[5]); o.w = pk2(v[6], v[7]);
            *(v4u*)(KDu + d * 64 + 8 * i8) = o; }
        if (t2 == 0) EG[unit] = __expf(gl);
    }
    __syncthreads();
}

__device__ __forceinline__ void gdn_g2_unit(LAS unsigned char* lds, int unit, bf16* PROJ, const float* UT, const bf16* NW, const bf16* QG, const bf16* KDT, const bf16* QK,
                                            const float* EG, float* outS, int tid, int lane, int wave) {
    const int bh = unit >> 3, sl = unit & 7, e0 = sl * 16, b = bh >> 2, h = bh & 3;
    const int fr = lane & 15, fq = lane >> 4; const bool role0 = wave < 4; const int tt = wave & 3;
    LAS unsigned char* Sl = lds;
    LAS unsigned char* Vl = lds + 4352;
    for (int i = tid; i < 4352 / 4; i += 512) ((LAS unsigned*)Sl)[i] = 0u;
    f32x4 Sacc = (f32x4){0.f, 0.f, 0.f, 0.f};
    bf16x8 cA1[4], cA2[2], cKD[2], nA1[4], nA2[2], nKD[2]; f32x4 cU, nU; float cEG, nEG;
#pragma unroll
    for (int k = 0; k < 2; ++k) { cA2[k] = (bf16x8){0, 0, 0, 0, 0, 0, 0, 0}; nA2[k] = cA2[k]; }
    cU = (f32x4){0.f, 0.f, 0.f, 0.f}; nU = cU;
#define G2_LOAD(c_, A1, A2, UU, KD, EGv) do { const size_t ub = (size_t)(bh * 32 + (c_)); \
        const bf16* p1 = (role0 ? NW : QG) + ub * 8192 + (16 * tt + fr) * 128 + 8 * fq; \
        _Pragma("unroll") for (int ks = 0; ks < 4; ++ks) A1[ks] = *(const bf16x8*)(p1 + 32 * ks); \
        if (role0) UU = *(const f32x4*)(UT + ub * 8192 + (e0 + fr) * 64 + 16 * tt + 4 * fq); \
        else { const bf16* p2 = QK + ub * 4096 + (16 * tt + fr) * 64 + 8 * fq; A2[0] = *(const bf16x8*)p2; A2[1] = *(const bf16x8*)(p2 + 32); } \
        const bf16* p3 = KDT + ub * 8192 + (16 * wave + fr) * 64 + 8 * fq; KD[0] = *(const bf16x8*)p3; KD[1] = *(const bf16x8*)(p3 + 32); EGv = EG[ub]; } while (0)
    G2_LOAD(0, cA1, cA2, cU, cKD, cEG);
    WG_BAR();
    for (int c = 0; c < 32; ++c) {
        if (c + 1 < 32) G2_LOAD(c + 1, nA1, nA2, nU, nKD, nEG);
        f32x4 a1 = role0 ? cU : (f32x4){0.f, 0.f, 0.f, 0.f};
#pragma unroll
        for (int ks = 0; ks < 4; ++ks) { const bf16x8 bS = *(const LAS bf16x8*)(Sl + fr * 272 + (32 * ks + 8 * fq) * 2); a1 = MFMA16(cA1[ks], bS, a1); }
        if (role0) { v2u o; o.x = pk2(a1.x, a1.y); o.y = pk2(a1.z, a1.w); *(LAS v2u*)(Vl + fr * 144 + (16 * tt + 4 * fq) * 2) = o; }
        WG_BAR();
        const bf16x8 bV0 = *(const LAS bf16x8*)(Vl + fr * 144 + (8 * fq) * 2), bV1 = *(const LAS bf16x8*)(Vl + fr * 144 + (32 + 8 * fq) * 2);
        if (!role0) {
            a1 = MFMA16(cA2[0], bV0, a1); a1 = MFMA16(cA2[1], bV1, a1);
            bf16* op = PROJ + (size_t)(b * TSEQ + 64 * c + 16 * tt + 4 * fq) * NPJ + CQ + h * 128 + e0 + fr;
            op[0] = (bf16)f2bf(a1.x); op[NPJ] = (bf16)f2bf(a1.y); op[2 * NPJ] = (bf16)f2bf(a1.z); op[3 * NPJ] = (bf16)f2bf(a1.w);
        }
        Sacc = Sacc * cEG;
        Sacc = MFMA16(cKD[0], bV0, Sacc); Sacc = MFMA16(cKD[1], bV1, Sacc);
        { v2u o; o.x = pk2(Sacc.x, Sacc.y); o.y = pk2(Sacc.z, Sacc.w); *(LAS v2u*)(Sl + fr * 272 + (16 * wave + 4 * fq) * 2) = o; }
        WG_BAR();
#pragma unroll
        for (int ks = 0; ks < 4; ++ks) cA1[ks] = nA1[ks];
        cA2[0] = nA2[0]; cA2[1] = nA2[1]; cKD[0] = nKD[0]; cKD[1] = nKD[1]; cU = nU; cEG = nEG;
    }
#undef G2_LOAD
    float* so = outS + ((size_t)bh * 128 + 16 * wave + 4 * fq) * 128 + e0 + fr;
    so[0] = Sacc.x; so[128] = Sacc.y; so[256] = Sacc.z; so[384] = Sacc.w;
    __syncthreads();
}
__device__ __forceinline__ void s5_prompt_unit(LAS unsigned char* lds, int unit, bf16* PROJ, const bf16* KMAT, const bf16* EPOW, const bf16* CPOW, const float* LAM32,
                                               const float* dskip, float* outRe, float* outIm, int tid, int lane, int wave) {
    const int b = unit >> 5, g = unit & 31;
    LAS unsigned char* UL = lds;
    LAS float* EL = (LAS float*)(lds + 66560);
    LAS unsigned char* HL = lds + 66560 + 33792;
    const int r = lane & 31, hh = lane >> 5;
    for (int piece = tid; piece < 4096; piece += 512) { const int tok = piece >> 1, hf = piece & 1;
        const v4u v = *(const v4u*)(PROJ + (size_t)(b * TSEQ + tok) * NPJ + CU + 16 * g + 8 * hf);
        *(LAS v4u*)(UL + (tok >> 5) * 1040 + (tok & 31) * 32 + hf * 16) = v; }
    __syncthreads();
    {
        const int mi = wave & 3, ni = wave >> 2;
        f32x16 acc;
#pragma unroll
        for (int i = 0; i < 16; ++i) acc[i] = 0.f;
        const bf16* ap = EPOW + ((size_t)((g * 4 + mi) * 32) * 64 + lane) * 8;
        const LAS unsigned char* bp = UL + (32 * ni + r) * 1040 + hh * 16;
#pragma unroll 8
        for (int kj = 0; kj < 32; ++kj) { const bf16x8 a = *(const bf16x8*)(ap + (size_t)kj * 512); const bf16x8 bq = *(const LAS bf16x8*)(bp + kj * 32); acc = MFMA32(a, bq, acc); }
#pragma unroll
        for (int i4 = 0; i4 < 4; ++i4) *(LAS f32x4*)(EL + (32 * ni + r) * 132 + 32 * mi + 8 * i4 + 4 * hh) = (f32x4){acc[4 * i4], acc[4 * i4 + 1], acc[4 * i4 + 2], acc[4 * i4 + 3]};
    }
    __syncthreads();
    if (wave == 0) {
        const float lr = LAM32[(g * 64 + lane) * 2], li = LAM32[(g * 64 + lane) * 2 + 1];
        float Hr = 0.f, Hi = 0.f;
        for (int c = 0; c < 64; ++c) {
            *(LAS unsigned short*)(HL + c * 272 + lane * 2) = (unsigned short)f2bf(Hr); *(LAS unsigned short*)(HL + c * 272 + (64 + lane) * 2) = (unsigned short)f2bf(Hi);
            const float er = EL[c * 132 + lane], ei = EL[c * 132 + 64 + lane];
            const float nr = lr * Hr - li * Hi + er, nim = lr * Hi + li * Hr + ei; Hr = nr; Hi = nim; }
        outRe[(size_t)(b * 32 + g) * 64 + lane] = Hr; outIm[(size_t)(b * 32 + g) * 64 + lane] = Hi;
    }
    __syncthreads();
    {
        f32x16 acc[2][2];
#pragma unroll
        for (int a = 0; a < 2; ++a)
#pragma unroll
            for (int n = 0; n < 2; ++n)
#pragma unroll
                for (int i = 0; i < 16; ++i) acc[a][n][i] = 0.f;
        const LAS unsigned char* bp0 = UL + (r) * 1040 + hh * 16; const LAS unsigned char* bp1 = UL + (32 + r) * 1040 + hh * 16;
#pragma unroll
        for (int a = 0; a < 2; ++a) { const int mt = a == 0 ? wave : 15 - wave;
            const bf16* ap = KMAT + ((size_t)((g * 16 + mt) * 32) * 64 + lane) * 8;
            const int nk = 2 * mt + 2;
            for (int kj = 0; kj < nk; ++kj) { const bf16x8 av = *(const bf16x8*)(ap + (size_t)kj * 512);
                const bf16x8 b0 = *(const LAS bf16x8*)(bp0 + kj * 32), b1 = *(const LAS bf16x8*)(bp1 + kj * 32);
                acc[a][0] = MFMA32(av, b0, acc[a][0]); acc[a][1] = MFMA32(av, b1, acc[a][1]); }
            const bf16* cp = CPOW + ((size_t)((g * 16 + mt) * 8) * 64 + lane) * 8;
#pragma unroll
            for (int kj = 0; kj < 8; ++kj) { const bf16x8 av = *(const bf16x8*)(cp + (size_t)kj * 512);
                const bf16x8 b0 = *(const LAS bf16x8*)(HL + r * 272 + (16 * kj + 8 * hh) * 2), b1 = *(const LAS bf16x8*)(HL + (32 + r) * 272 + (16 * kj + 8 * hh) * 2);
                acc[a][0] = MFMA32(av, b0, acc[a][0]); acc[a][1] = MFMA32(av, b1, acc[a][1]); }
        }
#pragma unroll
        for (int a = 0; a < 2; ++a) { const int mt = a == 0 ? wave : 15 - wave;
#pragma unroll
            for (int n = 0; n < 2; ++n)
#pragma unroll
                for (int i4 = 0; i4 < 4; ++i4) { const int ttk = i4 >> 1, c0 = 8 * (i4 & 1) + 4 * hh; const int chunk = 32 * n + r, tl = 2 * mt + ttk;
                    const v2u uu = *(const LAS v2u*)(UL + chunk * 1040 + tl * 32 + c0 * 2);
                    const f32x4 dk = *(const f32x4*)(dskip + 16 * g + c0);
                    const float y0 = acc[a][n][4 * i4] + dk.x * bflo(uu.x), y1 = acc[a][n][4 * i4 + 1] + dk.y * bfhi(uu.x), y2 = acc[a][n][4 * i4 + 2] + dk.z * bflo(uu.y), y3 = acc[a][n][4 * i4 + 3] + dk.w * bfhi(uu.y);
                    v2u o; o.x = pk2(gelu_tanh(y0), gelu_tanh(y1)); o.y = pk2(gelu_tanh(y2), gelu_tanh(y3));
                    *(v2u*)(PROJ + (size_t)(b * TSEQ + 32 * chunk + tl) * NPJ + CU + 16 * g + c0) = o; }
        }
    }
    __syncthreads();
}

__device__ __forceinline__ void gdn_sample_task(LAS unsigned char* lds, int task, bf16* PROJ, const float* wconv, const float* sconv, const float* sgdn, const float* Gg, const float* Bg,
                                                float* outS, float* outConv, int tid, int lane, int wave) {
    const int b = task >> 2, h = task & 3; const int m = MP + b;
    LAS float* qkv = (LAS float*)lds;
    LAS float* red = qkv + 384;
    LAS float* part = qkv + 512;
    LAS float* vnew = part + 1024;
    if (tid < 384) { const int mat = tid >> 7, d = tid & 127, ch = mat * 512 + h * 128 + d;
        const float* sc = sconv + (size_t)b * 3 * 1536 + ch; const float raw = bf2f(PROJ[(size_t)m * NPJ + ch]);
        const float s0 = sc[0], s1 = sc[1536], s2 = sc[3072];
        const float y = wconv[ch] * s0 + wconv[1536 + ch] * s1 + wconv[3072 + ch] * s2 + wconv[4608 + ch] * raw;
        qkv[tid] = siluf_(y);
        float* nc = outConv + (size_t)b * 3 * 1536 + ch; nc[0] = s1; nc[1536] = s2; nc[3072] = raw; }
    __syncthreads();
    if (wave < 3) { const float q0 = qkv[lane], q1 = qkv[64 + lane], k0 = qkv[128 + lane], k1 = qkv[192 + lane];
        float v = wave == 0 ? q0 * q0 + q1 * q1 : (wave == 1 ? k0 * k0 + k1 * k1 : q0 * k0 + q1 * k1);
        v = wave_sum(v); if (lane == 0) red[wave] = v; }
    __syncthreads();
    const float rq = rsqrtf(red[0] + EPS), rk = rsqrtf(red[1] + EPS), qkdot = red[2] * rq * rk * QSCALE;
    const float gv = Gg[(size_t)m * 4 + h], beta = Bg[(size_t)m * 4 + h], eg = __expf(gv);
    const int dg = tid >> 7, e = tid & 127;
    const float* S0 = sgdn + (size_t)(b * 4 + h) * 16384;
    float s[32]; float ks = 0.f, qs = 0.f;
#pragma unroll
    for (int dd = 0; dd < 32; ++dd) { const int d = dg * 32 + dd; s[dd] = S0[d * 128 + e]; ks += qkv[128 + d] * s[dd]; qs += qkv[d] * s[dd]; }
    part[dg * 128 + e] = ks * rk; part[512 + dg * 128 + e] = qs * rq * QSCALE;
    __syncthreads();
    if (tid < 128) { const float ksum = part[e] + part[128 + e] + part[256 + e] + part[384 + e], qsum = part[512 + e] + part[640 + e] + part[768 + e] + part[896 + e];
        const float vn = beta * (qkv[256 + e] - eg * ksum); const float o = eg * qsum + qkdot * vn; vnew[e] = vn;
        PROJ[(size_t)m * NPJ + CQ + h * 128 + e] = (bf16)f2bf(o); }
    __syncthreads();
    { const float vn = vnew[e]; float* So = outS + (size_t)(b * 4 + h) * 16384;
#pragma unroll
        for (int dd = 0; dd < 32; ++dd) { const int d = dg * 32 + dd; So[d * 128 + e] = s[dd] * eg + (qkv[128 + d] * rk) * vn; } }
    __syncthreads();
}

__device__ __forceinline__ void s5_sample_task(int task, bf16* PROJ, const float* LAMB, const float* BBAR, const float* cre, const float* cim, const float* dskip,
                                               const float* sre, const float* sim, float* outRe, float* outIm, int lane) {
    const int b = task >> 5, g = task & 31; const int m = MP + b;
    bf16* up = PROJ + (size_t)m * NPJ + CU + 16 * g;
    const v4u u0 = *(const v4u*)up, u1 = *(const v4u*)(up + 8);
    float u[16];
#pragma unroll
    for (int q = 0; q < 4; ++q) { u[2 * q] = bflo(u0[q]); u[2 * q + 1] = bfhi(u0[q]); u[8 + 2 * q] = bflo(u1[q]); u[8 + 2 * q + 1] = bfhi(u1[q]); }
    const size_t sp = (size_t)(b * 32 + g) * 64 + lane;
    const float h0r = sre[sp], h0i = sim[sp];
    const float lr = LAMB[(g * 64 + lane) * 2], li = LAMB[(g * 64 + lane) * 2 + 1];
    float bur = 0.f, bui = 0.f;
    const float* bb = BBAR + (size_t)(g * 64 + lane) * 32;
#pragma unroll
    for (int c4 = 0; c4 < 8; ++c4) { const f32x4 v = *(const f32x4*)(bb + 4 * c4); bur += v.x * u[2 * c4] + v.z * u[2 * c4 + 1]; bui += v.y * u[2 * c4] + v.w * u[2 * c4 + 1]; }
    const float hr = lr * h0r - li * h0i + bur, hi = lr * h0i + li * h0r + bui;
    outRe[sp] = hr; outIm[sp] = hi;
    float ys[16];
#pragma unroll
    for (int c = 0; c < 16; ++c) { float v = cre[(size_t)(g * 16 + c) * 64 + lane] * hr - cim[(size_t)(g * 16 + c) * 64 + lane] * hi; v = wave_sum(v); ys[c] = gelu_tanh(v + dskip[16 * g + c] * u[c]); }
    if (lane == 0) { v4u o0, o1;
        o0.x = pk2(ys[0], ys[1]); o0.y = pk2(ys[2], ys[3]); o0.z = pk2(ys[4], ys[5]); o0.w = pk2(ys[6], ys[7]);
        o1.x = pk2(ys[8], ys[9]); o1.y = pk2(ys[10], ys[11]); o1.z = pk2(ys[12], ys[13]); o1.w = pk2(ys[14], ys[15]);
        *(v4u*)up = o0; *(v4u*)(up + 8) = o1; }
}

__device__ __forceinline__ void ln_row(float* row, const float* gam, const float* bet, bf16* xb, int lane) {
    f32x4* xr = (f32x4*)row + lane;
    f32x4 v[4]; float s = 0.f;
#pragma unroll
    for (int j = 0; j < 4; ++j) { v[j] = xr[64 * j]; s += (v[j].x + v[j].y) + (v[j].z + v[j].w); }
    const float mean = wave_sum(s) * (1.f / 1024.f); float s2 = 0.f;
#pragma unroll
    for (int j = 0; j < 4; ++j) { v[j] = v[j] - mean; s2 += (v[j].x * v[j].x + v[j].y * v[j].y) + (v[j].z * v[j].z + v[j].w * v[j].w); }
    const float rstd = rsqrtf(wave_sum(s2) * (1.f / 1024.f) + EPS);
#pragma unroll
    for (int j = 0; j < 4; ++j) { const f32x4 gg = *((const f32x4*)gam + lane + 64 * j), bb = *((const f32x4*)bet + lane + 64 * j);
        const f32x4 o = v[j] * rstd * gg + bb; xr[64 * j] = o;
        if (xb) { v2u w; w.x = pk2(o.x, o.y); w.y = pk2(o.z, o.w); *((v2u*)xb + lane + 64 * j) = w; } }
}
#define XB_TMO      128
#define XB_XCNT(j)  (256  + 64 * (j))
#define XB_XSUB(j)  (1280 + 64 * (j))
#define XB_XGEN(j)  (2304 + 64 * (j))
#define XB_TOP      3328
#define XB_TOPGEN   3392
#define XCD_BAR_WORDS 3456
#define XB_SPIN_CAP (1u << 18)

__device__ __forceinline__ unsigned xb_ld(unsigned* p)              { return __hip_atomic_load(p, __ATOMIC_RELAXED, __HIP_MEMORY_SCOPE_AGENT); }
__device__ __forceinline__ unsigned xb_add(unsigned* p, unsigned v) { return __hip_atomic_fetch_add(p, v, __ATOMIC_RELAXED, __HIP_MEMORY_SCOPE_AGENT); }
__device__ __forceinline__ unsigned xb_xcc_id() { return (unsigned)__builtin_amdgcn_s_getreg((3 << 11) | 20) & 0xFu; }
#define XB_SPIN(cond, bar) do { unsigned _sp = 0; while (cond) { __builtin_amdgcn_s_sleep(1); \
    if ((++_sp & 255u) == 0u) { if (xb_ld(&(bar)[XB_TMO])) break; if (_sp > XB_SPIN_CAP) { atomicAdd(&(bar)[XB_TMO], 1u); break; } } } } while (0)

struct XcdBarrier {
    unsigned* bar; unsigned x;
    volatile LAS unsigned* st;
};

__device__ __forceinline__ XcdBarrier xcd_barrier_post(unsigned* bar, volatile LAS unsigned* st) {
    XcdBarrier b; b.bar = bar; b.x = xb_xcc_id(); b.st = st;
    if (threadIdx.x == 0) (void)xb_add(&bar[XB_XCNT(b.x)], 1u);
    return b;
}
__device__ __forceinline__ void xcd_barrier_complete(unsigned* bar, unsigned x, unsigned& nloc, unsigned& nx) {
    const unsigned G = gridDim.x * gridDim.y * gridDim.z;
    unsigned sum, cnt, mine, sp = 0u;
    for (;;) {
        sum = 0u; cnt = 0u; mine = 0u;
#pragma unroll
        for (unsigned j = 0; j < 16; ++j) { const unsigned c = xb_ld(&bar[XB_XCNT(j)]); sum += c; cnt += (c > 0u) ? 1u : 0u; mine = (j == x) ? c : mine; }
        if (sum == G) break;
        __builtin_amdgcn_s_sleep(1);
        if ((++sp & 255u) == 0u) { if (xb_ld(&bar[XB_TMO])) break; if (sp > XB_SPIN_CAP) { atomicAdd(&bar[XB_TMO], 1u); break; } }
    }
    nloc = mine > 0u ? mine : 1u; nx = cnt > 0u ? cnt : 1u;
}

__device__ __forceinline__ void xcd_barrier(const XcdBarrier& b) {
    asm volatile("s_waitcnt vmcnt(0)" ::: "memory");
    __syncthreads();
    if (threadIdx.x == 0) {
        unsigned* bar = b.bar;
        __builtin_amdgcn_s_waitcnt(0);
        unsigned nloc = b.st[0], nx = b.st[1];
        if (nloc == 0u) { xcd_barrier_complete(bar, b.x, nloc, nx); b.st[0] = nloc; b.st[1] = nx; }
        const unsigned old = xb_add(&bar[XB_XSUB(b.x)], 1u);
        const unsigned gen = old / nloc;
        if (old + 1u == (gen + 1u) * nloc) {
            __builtin_amdgcn_fence(__ATOMIC_RELEASE, "agent");
            asm volatile("s_waitcnt vmcnt(0)" ::: "memory");
            const unsigned og = xb_add(&bar[XB_TOP], 1u);
            const unsigned tg = og / nx;
            if (og + 1u == (tg + 1u) * nx) xb_add(&bar[XB_TOPGEN], 1u);
            else XB_SPIN(xb_ld(&bar[XB_TOPGEN]) == tg, bar);
            __builtin_amdgcn_fence(__ATOMIC_ACQUIRE, "agent");
            xb_add(&bar[XB_XGEN(b.x)], 1u);
            asm volatile("s_waitcnt vmcnt(0)" ::: "memory");
        } else {
            XB_SPIN(xb_ld(&bar[XB_XGEN(b.x)]) == gen, bar);
            __builtin_amdgcn_fence(__ATOMIC_ACQUIRE, "agent");
            asm volatile("s_waitcnt vmcnt(0)" ::: "memory");
        }
    }
    __syncthreads();
}

#ifndef P2SEL
#define P2SEL 15
#endif
#ifndef PHASES
#define PHASES 255
#endif
__global__ void __launch_bounds__(512, 2) hymba_fwd(Args a) {
    extern __shared__ __attribute__((aligned(16))) unsigned char lds_raw[];
    LAS unsigned char* lds = (LAS unsigned char*)lds_raw;
    cg::grid_group grid = cg::this_grid();
    const int tid = threadIdx.x, lane = tid & 63, wave = __builtin_amdgcn_readfirstlane(tid >> 6);
    const int G = gridDim.x, bid = blockIdx.x;
    const int gw = bid * 8 + wave, NGW = G * 8;
    unsigned char* ws = a.ws;
    const float *xP = a.in[0], *xS = a.in[1], *sgdn = a.in[2], *sconv = a.in[3], *sre = a.in[4], *sim = a.in[5], *w_in = a.in[6], *w_conv = a.in[7],
                *a_log = a.in[8], *dt_bias = a.in[9], *norm_w = a.in[10], *s5are = a.in[11], *s5aim = a.in[12], *s5bre = a.in[13], *s5bim = a.in[14],
                *s5cre = a.in[15], *s5cim = a.in[16], *s5d = a.in[17], *s5ldt = a.in[18], *w_glu = a.in[19], *b_glu = a.in[20], *w_out = a.in[21],
                *ln1g = a.in[22], *ln1b = a.in[23], *w_ff1 = a.in[24], *w_ff2 = a.in[25], *ln2g = a.in[26], *ln2b = a.in[27];
    float* out = a.out;
    bf16 *WI_t = (bf16*)(ws + WS_WI), *WGLU_t = (bf16*)(ws + WS_WGLU), *WO_t = (bf16*)(ws + WS_WO), *W1_t = (bf16*)(ws + WS_W1), *W2_t = (bf16*)(ws + WS_W2);
    float *Gg = (float*)(ws + WS_MISC + MO_G), *Bg = (float*)(ws + WS_MISC + MO_BETA), *EG = (float*)(ws + WS_MISC + MO_EG), *LAMB = (float*)(ws + WS_MISC + MO_LAMB),
          *LAM32 = (float*)(ws + WS_MISC + MO_LAM32), *BBAR = (float*)(ws + WS_MISC + MO_BBAR);
    bf16 *XB = (bf16*)(ws + WS_XB), *X1B = (bf16*)(ws + WS_XB), *MIXA = (bf16*)(ws + WS_MIXA), *KMAT = (bf16*)(ws + WS_KMAT), *EPOW = (bf16*)(ws + WS_EPOW), *CPOW = (bf16*)(ws + WS_CPOW);
    bf16 *PROJ = (bf16*)(ws + WS_PROJ), *HB = (bf16*)(ws + WS_H), *NW = (bf16*)(ws + WS_NW), *QG = (bf16*)(ws + WS_QG), *KDT = (bf16*)(ws + WS_KDT), *QK = (bf16*)(ws + WS_QK);
    float* UT = (float*)(ws + WS_XB);
    volatile LAS unsigned* xst = (volatile LAS unsigned*)(lds + LDS_BYTES - 64);
    if (tid < 2) xst[tid] = 0u;
    __syncthreads();
    XcdBarrier xbar = xcd_barrier_post((unsigned*)ws + 4096, xst);
#define GRID_BAR() xcd_barrier(xbar)

#if (PHASES >> 0) & 1
    {
        LAS float* scr = (LAS float*)(lds + wave * 16384);
        constexpr int I_WI = 16 * 80, I_GLU = 8 * 16, I_WO = 16 * 32, I_W1 = 16 * 128, I_W2 = 64 * 32, NIT = I_WI + I_GLU + I_WO + I_W1 + I_W2;
        for (int it = gw; it < NIT; it += NGW) {
            int r = it;
            if (r < I_WI) { p0_tr_item(w_in, 2568, 1024, 80, WI_t, scr, r, lane, 1); continue; } r -= I_WI;
            if (r < I_GLU) { p0_tr_item(w_glu, 512, 512, 16, WGLU_t, scr, r, lane, 0); continue; } r -= I_GLU;
            if (r < I_WO) { p0_tr_item(w_out, 1024, 1024, 32, WO_t, scr, r, lane, 0); continue; } r -= I_WO;
            if (r < I_W1) { p0_tr_item(w_ff1, 4096, 1024, 128, W1_t, scr, r, lane, 0); continue; } r -= I_W1;
            p0_tr_item(w_ff2, 1024, 4096, 32, W2_t, scr, r, lane, 0);
        }
        __syncthreads();
        LAS float* wg = (LAS float*)lds;
        for (int idx = tid; idx < 8192; idx += 512) { const int k = idx >> 3, c = idx & 7; wg[c * 1024 + k] = w_in[(size_t)k * 2568 + 2048 + c]; }
        __syncthreads();
        for (int m = gw; m < MPAD; m += NGW) {
            v2u* o8 = (v2u*)(XB + (size_t)m * 1024) + lane;
            if (m >= MR) {
#pragma unroll
                for (int j = 0; j < 4; ++j) o8[64 * j] = (v2u){0u, 0u};
                continue; }
            const f32x4* xr = (const f32x4*)(m < MP ? xP + (size_t)m * 1024 : xS + (size_t)(m - MP) * 1024) + lane;
            f32x4 v[4];
#pragma unroll
            for (int j = 0; j < 4; ++j) { v[j] = xr[64 * j]; v2u w; w.x = pk2(v[j].x, v[j].y); w.y = pk2(v[j].z, v[j].w); o8[64 * j] = w; }
            float d[8];
#pragma unroll
            for (int c = 0; c < 8; ++c) { float s = 0.f;
#pragma unroll
                for (int j = 0; j < 4; ++j) { const f32x4 w = *(const LAS f32x4*)(wg + c * 1024 + 256 * j + 4 * lane); s += v[j].x * w.x + v[j].y * w.y + v[j].z * w.z + v[j].w * w.w; }
                d[c] = wave_sum(s); }
            if (lane == 0) { f32x4 bt, gv;
#pragma unroll
                for (int hq = 0; hq < 4; ++hq) { bt[hq] = sigmf_(d[hq]); const float xx = d[4 + hq] + dt_bias[hq]; const float sp = xx > 20.f ? xx : log1pf(__expf(xx)); gv[hq] = -__expf(a_log[hq]) * sp; }
                *(f32x4*)(Bg + (size_t)m * 4) = bt; *(f32x4*)(Gg + (size_t)m * 4) = gv; }
        }
        __syncthreads();
        for (int job = bid; job < 256; job += G) {
            const int g = job >> 3, part = job & 7;
            LAS float* PW = (LAS float*)lds;
            LAS float* BB = PW + 4224;
            LAS float* CC = BB + 2048;
            LAS float* KL = CC + 2048;
            const float dt = __expf(s5ldt[g]);
            for (int idx = tid; idx < 33 * 64; idx += 512) { const int n = idx >> 6, p = idx & 63; const float are = s5are[g * 64 + p], aim = s5aim[g * 64 + p];
                const float mag = expf((float)n * are * dt); float sn, cs; sincosf((float)n * aim * dt, &sn, &cs); PW[idx * 2] = mag * cs; PW[idx * 2 + 1] = mag * sn; }
            for (int idx = tid; idx < 1024; idx += 512) { const int p = idx >> 4, c = idx & 15; const float are = s5are[g * 64 + p], aim = s5aim[g * 64 + p];
                const float mag = expf(are * dt); float sn, cs; sincosf(aim * dt, &sn, &cs); const float lr = mag * cs - 1.f, li = mag * sn; const float den = are * are + aim * aim;
                const float fr_ = (lr * are + li * aim) / den, fi_ = (li * are - lr * aim) / den;
                const float br = s5bre[(size_t)(g * 64 + p) * 16 + c], bi = s5bim[(size_t)(g * 64 + p) * 16 + c];
                const float vr = fr_ * br - fi_ * bi, vi = fr_ * bi + fi_ * br; BB[idx * 2] = vr; BB[idx * 2 + 1] = vi;
                if (part == 0) { BBAR[((size_t)(g * 64 + p) * 16 + c) * 2] = vr; BBAR[((size_t)(g * 64 + p) * 16 + c) * 2 + 1] = vi; } }
            for (int idx = tid; idx < 1024; idx += 512) { CC[idx * 2] = s5cre[(size_t)g * 1024 + idx]; CC[idx * 2 + 1] = s5cim[(size_t)g * 1024 + idx]; }
            if (part == 0 && tid < 64) { const float are = s5are[g * 64 + tid], aim = s5aim[g * 64 + tid]; float sn, cs;
                float mag = expf(are * dt); sincosf(aim * dt, &sn, &cs); LAMB[(g * 64 + tid) * 2] = mag * cs; LAMB[(g * 64 + tid) * 2 + 1] = mag * sn;
                mag = expf(32.f * are * dt); sincosf(32.f * aim * dt, &sn, &cs); LAM32[(g * 64 + tid) * 2] = mag * cs; LAM32[(g * 64 + tid) * 2 + 1] = mag * sn; }
            __syncthreads();
            for (int rr = 0; rr < 2; ++rr) { const int idx = tid + 512 * rr, dd = idx >> 8, c = (idx >> 4) & 15, c2 = idx & 15, d = 4 * part + dd;
                float s = 0.f;
                for (int p = 0; p < 64; ++p) { const float pr = PW[(d * 64 + p) * 2], pi = PW[(d * 64 + p) * 2 + 1], br = BB[(p * 16 + c2) * 2], bi = BB[(p * 16 + c2) * 2 + 1];
                    const float zr = pr * br - pi * bi, zi = pr * bi + pi * br; s += CC[(c * 64 + p) * 2] * zr - CC[(c * 64 + p) * 2 + 1] * zi; }
                KL[idx] = s; }
            __syncthreads();
            bf16* KM = KMAT + (size_t)g * 262144;
            for (int u = tid; u < 4096; u += 512) { const int dd = u >> 10, rem = u & 1023, t = rem >> 5, c = (rem >> 1) & 15, hq = rem & 1, d = 4 * part + dd;
                const int s = t - d;
                if (s >= 0) { const LAS float* kl = KL + dd * 256 + c * 16 + 8 * hq; v4u o; o.x = pk2(kl[0], kl[1]); o.y = pk2(kl[2], kl[3]); o.z = pk2(kl[4], kl[5]); o.w = pk2(kl[6], kl[7]);
                    *(v4u*)(KM + ((size_t)((t >> 1) * 32 + s) * 64 + hq * 32 + 16 * (t & 1) + c) * 8) = o; }
                const int s2 = t + d;
                if (d >= 1 && s2 < 32) *(v4u*)(KM + ((size_t)((t >> 1) * 32 + s2) * 64 + hq * 32 + 16 * (t & 1) + c) * 8) = (v4u){0u, 0u, 0u, 0u}; }
            bf16* EP = EPOW + (size_t)g * 65536;
            for (int u = tid; u < 1024; u += 512) { const int q = u >> 3, sdd = (u >> 1) & 3, hq = u & 1, s = 4 * part + sdd, p = q & 63, im = q >> 6, n = 31 - s;
                const float pr = PW[(n * 64 + p) * 2], pi = PW[(n * 64 + p) * 2 + 1]; float v[8];
#pragma unroll
                for (int j = 0; j < 8; ++j) { const float br = BB[(p * 16 + 8 * hq + j) * 2], bi = BB[(p * 16 + 8 * hq + j) * 2 + 1]; v[j] = im ? (pr * bi + pi * br) : (pr * br - pi * bi); }
                v4u o; o.x = pk2(v[0], v[1]); o.y = pk2(v[2], v[3]); o.z = pk2(v[4], v[5]); o.w = pk2(v[6], v[7]);
                *(v4u*)(EP + ((size_t)((q >> 5) * 32 + s) * 64 + hq * 32 + (q & 31)) * 8) = o; }
            bf16* CP = CPOW + (size_t)g * 65536;
            for (int u = tid; u < 1024; u += 512) { const int tdd = u >> 8, c = (u >> 4) & 15, q8 = u & 15, t = 4 * part + tdd, n = t + 1; float v[8];
#pragma unroll
                for (int j = 0; j < 8; ++j) { const int q = 8 * q8 + j, p = q & 63, im = q >> 6; const float pr = PW[(n * 64 + p) * 2], pi = PW[(n * 64 + p) * 2 + 1], cr = CC[(c * 64 + p) * 2], ci = CC[(c * 64 + p) * 2 + 1];
                    const float zr = cr * pr - ci * pi, zi = cr * pi + ci * pr; v[j] = im ? -zi : zr; }
                v4u o; o.x = pk2(v[0], v[1]); o.y = pk2(v[2], v[3]); o.z = pk2(v[4], v[5]); o.w = pk2(v[6], v[7]);
                *(v4u*)(CP + ((size_t)(((t >> 1) * 8 + (q8 >> 1)) * 64) + (q8 & 1) * 32 + 16 * (t & 1) + c) * 8) = o; }
            __syncthreads();
        }
    }
    grid.sync();

#endif
#if (PHASES >> 1) & 1
    { pg8::Gemm g{XB, WI_t, MPAD, NPJ, 1024, 1024}; pg8::StaticOrder S; S.init(MPAD, NPJ, G, bid);
      pg8::EpiBf16<0> E{PROJ, NPJ, nullptr, 0, 0, 1.f};
      pg8::gemm_phase<pg8::EpiBf16<0>, pg8::StaticOrder, true, true>(lds, g, S, E); }
    GRID_BAR();

#endif
#if (PHASES >> 2) & 1
#if P2SEL & 1
    for (int unit = bid; unit < 1024; unit += G) gdn_g1_unit(lds, unit, PROJ, w_conv, Gg, Bg, UT, NW, QG, KDT, QK, EG, tid, lane, wave);
    for (int idx = bid * 512 + tid; idx < 36864; idx += G * 512) { const int b = idx / 4608, rem = idx % 4608, r = rem / 1536, ch = rem % 1536;
        out[OUT_CONV_P + idx] = bf2f(PROJ[(size_t)(b * TSEQ + 2045 + r) * NPJ + ch]); }
#endif
#if P2SEL & 2
    for (int unit = bid; unit < 256; unit += G) s5_prompt_unit(lds, unit, PROJ, KMAT, EPOW, CPOW, LAM32, s5d, out + OUT_RE_P, out + OUT_IM_P, tid, lane, wave);
#endif
#if P2SEL & 4
    for (int task = bid; task < 512; task += G) gdn_sample_task(lds, task, PROJ, w_conv, sconv, sgdn, Gg, Bg, out + OUT_GDN_S, out + OUT_CONV_S, tid, lane, wave);
#endif
#if P2SEL & 8
    for (int task = gw; task < 4096; task += NGW) s5_sample_task(task, PROJ, LAMB, BBAR, s5cre, s5cim, s5d, sre, sim, out + OUT_RE_S, out + OUT_IM_S, lane);
#endif
    GRID_BAR();

#endif
#if (PHASES >> 3) & 1
    for (int unit = bid; unit < 256; unit += G) gdn_g2_unit(lds, unit, PROJ, UT, NW, QG, KDT, QK, EG, out + OUT_GDN_P, tid, lane, wave);
    GRID_BAR();

#endif
#if (PHASES >> 4) & 1
    for (int m = gw; m < MPAD; m += NGW) {
        v4u* op = (v4u*)(MIXA + (size_t)m * 1024) + lane;
        if (m >= MR) { *op = (v4u){0u, 0u, 0u, 0u}; continue; }
        const v4u o8 = *((const v4u*)(PROJ + (size_t)m * NPJ + CQ) + lane), z8 = *((const v4u*)(PROJ + (size_t)m * NPJ + CZ) + lane);
        float o[8], z[8];
#pragma unroll
        for (int q = 0; q < 4; ++q) { o[2 * q] = bflo(o8[q]); o[2 * q + 1] = bfhi(o8[q]); z[2 * q] = bflo(z8[q]); z[2 * q + 1] = bfhi(z8[q]); }
        float ss = 0.f;
#pragma unroll
        for (int q = 0; q < 8; ++q) ss += o[q] * o[q];
        ss += __shfl_xor(ss, 1); ss += __shfl_xor(ss, 2); ss += __shfl_xor(ss, 4); ss += __shfl_xor(ss, 8);
        const float rn = rsqrtf(ss * (1.f / 128.f) + EPS);
        const f32x4 n0 = *(const f32x4*)(norm_w + ((8 * lane) & 127)), n1 = *(const f32x4*)(norm_w + ((8 * lane) & 127) + 4);
        float r[8];
#pragma unroll
        for (int q = 0; q < 4; ++q) { r[q] = o[q] * rn * n0[q] * siluf_(z[q]); r[4 + q] = o[4 + q] * rn * n1[q] * siluf_(z[4 + q]); }
        v4u w; w.x = pk2(r[0], r[1]); w.y = pk2(r[2], r[3]); w.z = pk2(r[4], r[5]); w.w = pk2(r[6], r[7]); *op = w;
    }
    { pg8::Gemm g{PROJ + CU, WGLU_t, MPAD, 512, 512, NPJ}; pg8::StaticOrder S; S.init(MPAD, 512, G, bid);
      pg8::EpiGlu E{MIXA, 1024, 512, PROJ, NPJ, CU, b_glu};
      pg8::gemm_phase<pg8::EpiGlu, pg8::StaticOrder, true, true>(lds, g, S, E); }
    GRID_BAR();

#endif
#if (PHASES >> 5) & 1
    { pg8::Gemm g{MIXA, WO_t, MPAD, 1024, 1024, 1024}; pg8::StaticOrder S; S.init(MPAD, 1024, G, bid);
      pg8::EpiResF32 E{xP, xS, out, DN_ALPHA, MP, MR};
      pg8::gemm_phase<pg8::EpiResF32, pg8::StaticOrder, true, true>(lds, g, S, E); }
    GRID_BAR();
    for (int m = gw; m < MPAD; m += NGW) {
        if (m >= MR) { v2u* o8 = (v2u*)(X1B + (size_t)m * 1024) + lane;
#pragma unroll
            for (int j = 0; j < 4; ++j) o8[64 * j] = (v2u){0u, 0u};
            continue; }
        ln_row(out + (size_t)m * 1024, ln1g, ln1b, X1B + (size_t)m * 1024, lane);
    }
    GRID_BAR();

#endif
#if (PHASES >> 6) & 1
    { pg8::Gemm g{X1B, W1_t, MPAD, DFF, 1024, 1024}; pg8::StaticOrder S; S.init(MPAD, DFF, G, bid);
      pg8::EpiRelu2 E{HB, DFF};
      pg8::gemm_phase<pg8::EpiRelu2, pg8::StaticOrder, true, true>(lds, g, S, E); }
    GRID_BAR();

#endif
#if (PHASES >> 7) & 1
    { pg8::Gemm g{HB, W2_t, MPAD, 1024, DFF, DFF}; pg8::StaticOrder S; S.init(MPAD, 1024, G, bid);
      pg8::EpiResF32 E{out, out + (size_t)MP * 1024, out, DN_ALPHA, MP, MR};
      pg8::gemm_phase<pg8::EpiResF32, pg8::StaticOrder, true, true>(lds, g, S, E); }
    GRID_BAR();
    for (int m = gw; m < MR; m += NGW) ln_row(out + (size_t)m * 1024, ln2g, ln2b, nullptr, lane);
#endif
}

extern "C" void kernel_launch(void* const* d_in, const int* in_sizes, int n_in, void* d_out, int out_size, void* d_ws, size_t ws_size, hipStream_t stream) {
    static int grid = 0;
    if (grid == 0) {
        if (n_in != 28 || (size_t)out_size != OUT_TOTAL || ws_size < WS_END) { fprintf(stderr, "kernel_launch: unexpected shapes (n_in %d out %d ws %zu)\n", n_in, out_size, ws_size); grid = -1; return; }
        int dev = 0, cus = 0, per_cu = 0;
        hipGetDevice(&dev); hipDeviceGetAttribute(&cus, hipDeviceAttributeMultiprocessorCount, dev);
        if (hipFuncSetAttribute((const void*)hymba_fwd, hipFuncAttributeMaxDynamicSharedMemorySize, LDS_BYTES) != hipSuccess) { fprintf(stderr, "kernel_launch: hipFuncSetAttribute failed\n"); grid = -1; return; }
        if (hipOccupancyMaxActiveBlocksPerMultiprocessor(&per_cu, (const void*)hymba_fwd, 512, LDS_BYTES) != hipSuccess || per_cu < 1) { fprintf(stderr, "kernel_launch: occupancy query says %d\n", per_cu); per_cu = 1; }
        (void)hipGetLastError();
        grid = cus;
    }
    if (grid < 0) return;
    if (hipMemsetAsync(d_ws, 0, 65536, stream) != hipSuccess) { fprintf(stderr, "kernel_launch: memset failed\n"); return; }
    Args a{};
    for (int i = 0; i < 28; ++i) a.in[i] = (const float*)d_in[i];
    a.out = (float*)d_out; a.ws = (unsigned char*)d_ws;
    void* args[] = {&a};
    hipError_t e = hipLaunchCooperativeKernel((const void*)hymba_fwd, dim3(grid), dim3(512), args, LDS_BYTES, stream);
    if (e != hipSuccess) fprintf(stderr, "cooperative launch failed: %s (grid %d)\n", hipGetErrorString(e), grid);
}
```
